# Optimizing an MI355X kernel written in HIP

```python
import math
import jax
import jax.numpy as jnp
from jax import lax
import numpy as np

D_MODEL = 1024
BATCH = 8
SEQ = 4096
DEPTH = 2
DEC_BATCH = 32
DEC_SEQ = 8
PAST_LEN = 16384
PAGE_SIZE = 128

HEAD_DIM = 64
NSA_HEADS = 12
NSA_KV_HEADS = 2
NSA_GROUP = NSA_HEADS // NSA_KV_HEADS
NSA_WIDTH = NSA_HEADS * HEAD_DIM
NSA_KV_WIDTH = NSA_KV_HEADS * HEAD_DIM
CMP_BLOCK = 64
CMP_HIDDEN = 128
SLC_BLOCK = CMP_BLOCK
SLC_TOPN = 16
WINDOW = 512
Q_CHUNK = 64
FORCED_SCORE = 1e4
XATTN_HEADS = 4
XATTN_WIDTH = XATTN_HEADS * HEAD_DIM
N_MEM = 256
POOL_WINDOWS = (2, 4, 8, 16)
POOL_GROUPS = len(POOL_WINDOWS)
POOL_GROUP_DIM = 192
POOL_WIDTH = POOL_GROUPS * POOL_GROUP_DIM
POOL_STATE = max(POOL_WINDOWS) - 1
MIX_WIDTH = NSA_WIDTH + XATTN_WIDTH
NSA_IN_WIDTH = NSA_WIDTH + 6 * NSA_KV_WIDTH + 3 * NSA_HEADS + XATTN_WIDTH
POOL_IN_WIDTH = POOL_WIDTH + XATTN_WIDTH
D_FF = 2816
CONV_WIDTH = 3
REL_BUCKETS = 32
REL_MAX_DIST = 128
N_NSA_LAYERS = (DEPTH + 1) // 2
N_POOL_LAYERS = DEPTH // 2
EPS = 1e-6
NEG_INF = -1e30

kernel_name = 'nsa_pool_hybrid_decode_step'


def rmsnorm(x, g):
    xf = x.astype(jnp.float32)
    y = xf * lax.rsqrt(jnp.mean(xf * xf, axis=-1, keepdims=True) + EPS)
    return (y * g.astype(jnp.float32)).astype(x.dtype)


def rel_bucket(dist):
    n = jnp.maximum(dist, 0)
    max_exact = REL_BUCKETS // 2
    nf = jnp.maximum(n, 1).astype(jnp.float32)
    large = max_exact + (jnp.log(nf / max_exact) / math.log(REL_MAX_DIST / max_exact)
                         * (REL_BUCKETS - max_exact)).astype(jnp.int32)
    large = jnp.minimum(large, REL_BUCKETS - 1)
    return jnp.where(n < max_exact, n, large)


def masked_softmax(logits, mask):
    p = jax.nn.softmax(jnp.where(mask, logits, NEG_INF), axis=-1)
    return jnp.where(mask, p, 0.0)


def compress(rows, pos, w1, b1, w2, b2):
    b, lc, g, dh = rows.shape
    blk = rows.reshape(b, lc // CMP_BLOCK, CMP_BLOCK, g, dh) + pos[None, None, :, None, :]
    h = jax.nn.gelu(jnp.einsum('bclgd,ldh->bcgh', blk, w1) + b1)
    return jnp.einsum('bcgh,hd->bcgd', h, w2) + b2


def nsa_sources(full, k_gain, cmp_params):
    cpos, cw1, cb1, cw2, cb2 = cmp_params
    b, l, _, g, dh = full.shape
    nc = l // CMP_BLOCK
    rc = full[:, :nc * CMP_BLOCK]
    kc = rmsnorm(compress(rc[:, :, 0], cpos[0], cw1[0], cb1[0], cw2[0], cb2[0]), k_gain)
    vc = compress(rc[:, :, 1], cpos[1], cw1[1], cb1[1], cw2[1], cb2[1])
    c_end = jnp.arange(nc, dtype=jnp.int32) * CMP_BLOCK + (CMP_BLOCK - 1)
    nb = -(-l // SLC_BLOCK)
    sel = jnp.pad(full[:, :, 2:4], ((0, 0), (0, nb * SLC_BLOCK - l), (0, 0), (0, 0), (0, 0)))
    sel = sel.reshape(b, nb, SLC_BLOCK, 2, g, dh)
    return kc, vc, c_end, sel[:, :, :, 0], sel[:, :, :, 1]


def nsa_attend(q, q_pos, gates, kc, vc, c_end, ks_blk, vs_blk, kw, vw, kw_pos, rel_bias):
    b, nq, g, r, dh = q.shape
    scale = dh ** -0.5
    nb = ks_blk.shape[1]
    nc = kc.shape[1]
    d_c = q_pos[:, None] - c_end[None, :]
    bias_c = rel_bias[rel_bucket(d_c)].transpose(2, 0, 1).reshape(g, r, nq, nc)
    l_c = jnp.einsum('bqgrd,bcgd->bgrqc', q, kc).astype(jnp.float32) * scale + bias_c
    p_c = masked_softmax(l_c, d_c >= 0)
    o_c = jnp.einsum('bgrqc,bcgd->bqgrd', p_c.astype(vc.dtype), vc)
    blk = jnp.arange(nb, dtype=jnp.int32)[None, :]
    cur = (q_pos // SLC_BLOCK)[:, None]
    valid = blk * SLC_BLOCK <= q_pos[:, None]
    forced = (blk == 0) | (blk == cur) | (blk == cur - 1)
    imp = jnp.pad(p_c.sum(axis=2), ((0, 0), (0, 0), (0, 0), (0, nb - nc)))
    score = jnp.where(valid, jnp.where(forced, FORCED_SCORE, imp), -1.0)
    top_val, top_idx = lax.top_k(score, min(SLC_TOPN, nb))
    n_sel = top_idx.shape[-1]
    bi = jnp.arange(b)[:, None, None, None]
    gi = jnp.arange(g)[None, :, None, None]
    k_sel = ks_blk.transpose(0, 3, 1, 2, 4)[bi, gi, top_idx]
    v_sel = vs_blk.transpose(0, 3, 1, 2, 4)[bi, gi, top_idx]
    pos_sel = top_idx[..., None] * SLC_BLOCK + jnp.arange(SLC_BLOCK, dtype=jnp.int32)
    d_s = q_pos[None, None, :, None, None] - pos_sel
    m_s = ((d_s >= 0) & (top_val >= 0.0)[..., None]).reshape(b, g, 1, nq, n_sel * SLC_BLOCK)
    rb = rel_bias.reshape(REL_BUCKETS, g, r)
    bias_s = jnp.moveaxis(rb[rel_bucket(d_s), gi[..., None]], -1, 2).reshape(b, g, r, nq, n_sel * SLC_BLOCK)
    l_s = jnp.einsum('bqgrd,bgqkld->bgrqkl', q, k_sel).astype(jnp.float32)
    l_s = l_s.reshape(b, g, r, nq, n_sel * SLC_BLOCK) * scale + bias_s
    p_s = masked_softmax(l_s, m_s)
    o_s = jnp.einsum('bgrqn,bgqnd->bqgrd', p_s.astype(v_sel.dtype),
                     v_sel.reshape(b, g, nq, n_sel * SLC_BLOCK, dh))
    d_w = q_pos[:, None] - kw_pos[None, :]
    m_w = (d_w >= 0) & (d_w <= WINDOW) & (kw_pos >= 0)[None, :]
    bias_w = rel_bias[rel_bucket(d_w)].transpose(2, 0, 1).reshape(g, r, nq, kw_pos.shape[0])
    l_w = jnp.einsum('bqgrd,bwgd->bgrqw', q, kw).astype(jnp.float32) * scale + bias_w
    p_w = masked_softmax(l_w, m_w)
    o_w = jnp.einsum('bgrqw,bwgd->bqgrd', p_w.astype(vw.dtype), vw)
    o = gates[..., 0:1] * o_c + gates[..., 1:2] * o_s + gates[..., 2:3] * o_w
    return o.reshape(b, nq, g * r * dh)


def nsa_mix(z, q_gain, k_gain, cmp_params, rel_bias, past_rows, win_buf):
    b, l, _ = z.shape
    o1 = NSA_WIDTH + 6 * NSA_KV_WIDTH
    q = rmsnorm(z[..., :NSA_WIDTH].reshape(b, l, NSA_HEADS, HEAD_DIM), q_gain)
    q = q.reshape(b, l, NSA_KV_HEADS, NSA_GROUP, HEAD_DIM)
    kv = z[..., NSA_WIDTH:o1].reshape(b, l, 6, NSA_KV_HEADS, HEAD_DIM)
    gates = jax.nn.sigmoid(z[..., o1:o1 + 3 * NSA_HEADS]).reshape(b, l, NSA_KV_HEADS, NSA_GROUP, 3)
    k_slc = rmsnorm(kv[:, :, 2], k_gain)
    k_win = rmsnorm(kv[:, :, 4], k_gain)
    new_rows = jnp.stack([kv[:, :, 0], kv[:, :, 1], k_slc, kv[:, :, 3]], axis=2)
    win_rows = jnp.stack([k_win, kv[:, :, 5]], axis=2)
    if past_rows is None:
        pos0 = 0
        full = new_rows
    else:
        pos0 = past_rows.shape[1]
        full = jnp.concatenate([past_rows, new_rows], axis=1)
    kc, vc, c_end, ks_blk, vs_blk = nsa_sources(full, k_gain, cmp_params)
    if win_buf is None:
        win_pad = jnp.pad(win_rows, ((0, 0), (WINDOW, 0), (0, 0), (0, 0), (0, 0)))

        def chunk(i):
            s0 = i * Q_CHUNK
            qc = lax.dynamic_slice_in_dim(q, s0, Q_CHUNK, axis=1)
            gc = lax.dynamic_slice_in_dim(gates, s0, Q_CHUNK, axis=1)
            wc = lax.dynamic_slice_in_dim(win_pad, s0, WINDOW + Q_CHUNK, axis=1)
            q_pos = s0 + jnp.arange(Q_CHUNK, dtype=jnp.int32)
            kw_pos = s0 - WINDOW + jnp.arange(WINDOW + Q_CHUNK, dtype=jnp.int32)
            return nsa_attend(qc, q_pos, gc, kc, vc, c_end, ks_blk, vs_blk,
                              wc[:, :, 0], wc[:, :, 1], kw_pos, rel_bias)

        outs = lax.map(chunk, jnp.arange(l // Q_CHUNK, dtype=jnp.int32))
        out = outs.transpose(1, 0, 2, 3).reshape(b, l, NSA_WIDTH)
        new_win = win_rows[:, -min(WINDOW, l):]
    else:
        wb = win_buf.shape[1]
        wall = jnp.concatenate([win_buf, win_rows], axis=1)
        q_pos = pos0 + jnp.arange(l, dtype=jnp.int32)
        kw_pos = pos0 - wb + jnp.arange(wb + l, dtype=jnp.int32)
        out = nsa_attend(q, q_pos, gates, kc, vc, c_end, ks_blk, vs_blk,
                         wall[:, :, 0], wall[:, :, 1], kw_pos, rel_bias)
        new_win = wall[:, -wb:]
    return out, new_rows, new_win


def pool_mix(u, pos0, prev, w_grp, scale):
    b, l, _ = u.shape
    ext = jnp.concatenate([prev, u], axis=1).astype(jnp.float32)
    cs = jnp.cumsum(jnp.pad(ext, ((0, 0), (1, 0), (0, 0))), axis=1)
    pos = pos0 + jnp.arange(l, dtype=jnp.int32)
    e0 = POOL_STATE + 1
    outs = []
    for gidx, w in enumerate(POOL_WINDOWS):
        sl = slice(gidx * POOL_GROUP_DIM, (gidx + 1) * POOL_GROUP_DIM)
        s = cs[:, e0:e0 + l, sl] - cs[:, e0 - w:e0 - w + l, sl]
        cnt = jnp.minimum(w, pos + 1).astype(jnp.float32)[None, :, None]
        outs.append(s / cnt)
    pooled = (jnp.concatenate(outs, axis=-1) - u.astype(jnp.float32)).astype(u.dtype)
    mixed = jnp.einsum('blgc,gcd->blgd', pooled.reshape(b, l, POOL_GROUPS, POOL_GROUP_DIM), w_grp)
    return mixed.reshape(b, l, POOL_WIDTH) * scale, ext[:, -POOL_STATE:].astype(u.dtype)


def memory_kv(mem, g_mem, w_mem_kv, xk_gain):
    b, m, _ = mem.shape
    kv = (rmsnorm(mem, g_mem) @ w_mem_kv).reshape(b, m, 2, XATTN_HEADS, HEAD_DIM)
    return jnp.stack([rmsnorm(kv[:, :, 0], xk_gain), kv[:, :, 1]], axis=2)


def memory_attend(zq, xq_gain, mkv):
    b, l, _ = zq.shape
    q = rmsnorm(zq.reshape(b, l, XATTN_HEADS, HEAD_DIM), xq_gain)
    logits = jnp.einsum('blhd,bmhd->bhlm', q, mkv[:, :, 0]).astype(jnp.float32) * HEAD_DIM ** -0.5
    p = jax.nn.softmax(logits, axis=-1).astype(mkv.dtype)
    return jnp.einsum('bhlm,bmhd->blhd', p, mkv[:, :, 1]).reshape(b, l, XATTN_WIDTH)


def conv_ffn(h, prev, w_up, conv_w, conv_b, w_down):
    l = h.shape[1]
    u = h @ w_up
    ext = jnp.concatenate([prev, u], axis=1)
    y = conv_b + sum(conv_w[k] * ext[:, k:k + l] for k in range(CONV_WIDTH))
    a, v = jnp.split(y, 2, axis=-1)
    return (jax.nn.silu(a) * v) @ w_down, ext[:, -(CONV_WIDTH - 1):]


def setup_inputs(seed: int = 0) -> dict:
    key = jax.random.key(seed)
    keys = iter(jax.random.split(key, 48))

    def nrm(shape, scale):
        return jax.random.normal(next(keys), shape, jnp.float32) * scale

    n_pages = PAST_LEN // PAGE_SIZE
    n_used = DEC_BATCH * n_pages
    n_phys = n_used + (n_used + 3) // 4
    wb = min(WINDOW, PAST_LEN)
    page_table = jax.random.permutation(next(keys), n_phys)[:n_used].reshape(DEC_BATCH, n_pages).astype(jnp.int32)
    return {
        'x_prompt': nrm((BATCH, SEQ, D_MODEL), 1.0),
        'x_sample': nrm((DEC_BATCH, DEC_SEQ, D_MODEL), 1.0),
        'cache_nsa_kv': nrm((N_NSA_LAYERS, n_phys, PAGE_SIZE, 4, NSA_KV_HEADS, HEAD_DIM), 1.0),
        'cache_nsa_win': nrm((N_NSA_LAYERS, DEC_BATCH, wb, 2, NSA_KV_HEADS, HEAD_DIM), 1.0),
        'cache_mem_kv': nrm((DEPTH, DEC_BATCH, N_MEM, 2, XATTN_HEADS, HEAD_DIM), 1.0),
        'state_pool': nrm((N_POOL_LAYERS, DEC_BATCH, POOL_STATE, POOL_WIDTH), 1.0),
        'state_ffn_conv': nrm((DEPTH, DEC_BATCH, CONV_WIDTH - 1, 2 * D_FF), 1.0),
        'page_table': page_table,
        'mem_prompt': nrm((BATCH, N_MEM, D_MODEL), 1.0),
        'rel_bias': nrm((REL_BUCKETS, NSA_HEADS), 0.5),
        'g_mix': 1.0 + nrm((DEPTH, D_MODEL), 0.05),
        'g_mem': 1.0 + nrm((DEPTH, D_MODEL), 0.05),
        'g_ffn': 1.0 + nrm((DEPTH, D_MODEL), 0.05),
        'w_in_nsa': nrm((N_NSA_LAYERS, D_MODEL, NSA_IN_WIDTH), D_MODEL ** -0.5),
        'q_gain_nsa': 1.0 + nrm((N_NSA_LAYERS, HEAD_DIM), 0.05),
        'k_gain_nsa': 1.0 + nrm((N_NSA_LAYERS, HEAD_DIM), 0.05),
        'cmp_pos': nrm((N_NSA_LAYERS, 2, CMP_BLOCK, HEAD_DIM), 0.1),
        'cmp_w1': nrm((N_NSA_LAYERS, 2, CMP_BLOCK, HEAD_DIM, CMP_HIDDEN), (CMP_BLOCK * HEAD_DIM) ** -0.5),
        'cmp_b1': nrm((N_NSA_LAYERS, 2, CMP_HIDDEN), 0.01),
        'cmp_w2': nrm((N_NSA_LAYERS, 2, CMP_HIDDEN, HEAD_DIM), CMP_HIDDEN ** -0.5),
        'cmp_b2': nrm((N_NSA_LAYERS, 2, HEAD_DIM), 0.01),
        'w_in_pool': nrm((N_POOL_LAYERS, D_MODEL, POOL_IN_WIDTH), D_MODEL ** -0.5),
        'w_pool_grp': nrm((N_POOL_LAYERS, POOL_GROUPS, POOL_GROUP_DIM, POOL_GROUP_DIM), POOL_GROUP_DIM ** -0.5),
        'pool_scale': 1.0 + nrm((N_POOL_LAYERS, POOL_WIDTH), 0.05),
        'w_mem_kv': nrm((DEPTH, D_MODEL, 2 * XATTN_WIDTH), D_MODEL ** -0.5),
        'xq_gain': 1.0 + nrm((DEPTH, HEAD_DIM), 0.05),
        'xk_gain': 1.0 + nrm((DEPTH, HEAD_DIM), 0.05),
        'w_out': nrm((DEPTH, MIX_WIDTH, D_MODEL), MIX_WIDTH ** -0.5),
        'w_up': nrm((DEPTH, D_MODEL, 2 * D_FF), D_MODEL ** -0.5),
        'conv_w': nrm((DEPTH, CONV_WIDTH, 2 * D_FF), CONV_WIDTH ** -0.5),
        'conv_b': nrm((DEPTH, 2 * D_FF), 0.01),
        'w_down': nrm((DEPTH, D_FF, D_MODEL), D_FF ** -0.5),
    }


def reference(x_prompt, x_sample, cache_nsa_kv, cache_nsa_win, cache_mem_kv, state_pool, state_ffn_conv,
              page_table, mem_prompt, rel_bias, g_mix, g_mem, g_ffn, w_in_nsa, q_gain_nsa, k_gain_nsa,
              cmp_pos, cmp_w1, cmp_b1, cmp_w2, cmp_b2, w_in_pool, w_pool_grp, pool_scale, w_mem_kv,
              xq_gain, xk_gain, w_out, w_up, conv_w, conv_b, w_down):
    n_pages = page_table.shape[1]
    past_len = n_pages * PAGE_SIZE
    yp, ys = x_prompt, x_sample
    bp, bs = yp.shape[0], ys.shape[0]
    nsa_kv_p, nsa_kv_s, nsa_win_p, nsa_win_s = [], [], [], []
    mem_kv_p, pool_p, pool_s, conv_p, conv_s = [], [], [], [], []
    for i in range(DEPTH):
        j = i // 2
        xn_p = rmsnorm(yp, g_mix[i])
        xn_s = rmsnorm(ys, g_mix[i])
        mkv_p = memory_kv(mem_prompt, g_mem[i], w_mem_kv[i], xk_gain[i])
        mkv_s = cache_mem_kv[i]
        mem_kv_p.append(mkv_p)
        if i % 2 == 0:
            zp = xn_p @ w_in_nsa[j]
            zs = xn_s @ w_in_nsa[j]
            cmp_params = (cmp_pos[j], cmp_w1[j], cmp_b1[j], cmp_w2[j], cmp_b2[j])
            past_rows = cache_nsa_kv[j, page_table].reshape(bs, past_len, 4, NSA_KV_HEADS, HEAD_DIM)
            mix_p, rows_p, win_p = nsa_mix(zp, q_gain_nsa[j], k_gain_nsa[j], cmp_params, rel_bias, None, None)
            mix_s, rows_s, win_s = nsa_mix(zs, q_gain_nsa[j], k_gain_nsa[j], cmp_params, rel_bias,
                                           past_rows, cache_nsa_win[j])
            nsa_kv_p.append(rows_p)
            nsa_kv_s.append(rows_s)
            nsa_win_p.append(win_p)
            nsa_win_s.append(win_s)
        else:
            zp = xn_p @ w_in_pool[j]
            zs = xn_s @ w_in_pool[j]
            mix_p, st_p = pool_mix(zp[..., :POOL_WIDTH], 0, jnp.zeros((bp, POOL_STATE, POOL_WIDTH), zp.dtype),
                                   w_pool_grp[j], pool_scale[j])
            mix_s, st_s = pool_mix(zs[..., :POOL_WIDTH], past_len, state_pool[j], w_pool_grp[j], pool_scale[j])
            pool_p.append(st_p)
            pool_s.append(st_s)
        att_p = memory_attend(zp[..., -XATTN_WIDTH:], xq_gain[i], mkv_p)
        att_s = memory_attend(zs[..., -XATTN_WIDTH:], xq_gain[i], mkv_s)
        yp = yp + jnp.concatenate([mix_p, att_p], axis=-1) @ w_out[i]
        ys = ys + jnp.concatenate([mix_s, att_s], axis=-1) @ w_out[i]
        f_p, c_p = conv_ffn(rmsnorm(yp, g_ffn[i]), jnp.zeros((bp, CONV_WIDTH - 1, 2 * D_FF), yp.dtype),
                            w_up[i], conv_w[i], conv_b[i], w_down[i])
        f_s, c_s = conv_ffn(rmsnorm(ys, g_ffn[i]), state_ffn_conv[i], w_up[i], conv_w[i], conv_b[i], w_down[i])
        yp = yp + f_p
        ys = ys + f_s
        conv_p.append(c_p)
        conv_s.append(c_s)
    return (yp, ys, jnp.stack(nsa_kv_p), jnp.stack(nsa_kv_s), jnp.stack(nsa_win_p), jnp.stack(nsa_win_s),
            jnp.stack(mem_kv_p), jnp.stack(pool_p), jnp.stack(pool_s), jnp.stack(conv_p), jnp.stack(conv_s))
```

```cpp
#include <hip/hip_runtime.h>
#include <cstdio>
#include <cstdint>
#define MK_N_LAUNCHES 1
namespace pg8 {
#define PG8_LAS __attribute__((address_space(3)))
typedef unsigned short bf16_t;
typedef short bf16x8 __attribute__((ext_vector_type(8)));
typedef float f32x4 __attribute__((ext_vector_type(4)));
typedef unsigned u32x4 __attribute__((ext_vector_type(4)));
constexpr int BM = 256, BK = 64, HALF = 128, HTB = HALF * BK * 2  , STAGE_BYTES = 8 * HTB, NXCD = 8, WGM = 8;

__host__ __device__ __forceinline__ int lds_byte(int r, int c) { const int st = (r >> 4) * 2 + (c >> 5), rr = r & 15, cc = c & 31, ob = rr * 64 + cc * 2; return st * 1024 + (ob ^ (((ob >> 9) & 1) << 5)); }
__host__ __device__ __forceinline__ void stage_rc(int b, int& R, int& C) { const int st = b / 1024, sb = b % 1024, swz = sb ^ (((sb >> 9) & 1) << 5); R = (st >> 1) * 16 + swz / 64; C = (st & 1) * 32 + (swz % 64) / 2; }
__host__ __device__ __forceinline__ int perm32(int rho) { const int n = rho >> 4, i = rho & 15; return 8 * (i >> 2) + 4 * n + (i & 3); }

struct Unit { int pm, pn, kc; };
struct Gemm { const bf16_t* A; const bf16_t* Bt; int M, N, K; int Kloop; };

struct StaticOrder {
    int nM, nN, nwg, G, c;
    __host__ __device__ void init(int M, int N, int G_, int c_) { nM = M / BM; nN = N / BM; nwg = nM * nN; G = G_; c = c_; }
    __host__ __device__ bool next(int i, Unit& u) const {
        const long L = (long)i * G + c; if (L >= nwg) return false;
        int wgid = (int)L; { const int q = nwg / NXCD, r = nwg % NXCD, xcd = wgid % NXCD, off = wgid / NXCD; wgid = (xcd < r ? xcd * (q + 1) : r * (q + 1) + (xcd - r) * q) + off; }
        const int nig = WGM * nN, gid = wgid / nig, fm = gid * WGM, gsz = (nM - fm) < WGM ? (nM - fm) : WGM;
        u.pm = fm + ((wgid % nig) % gsz); u.pn = (wgid % nig) / gsz; u.kc = 0; return true;
    }
    __device__ __forceinline__ void a_ready(const Unit&) const {}
    __device__ __forceinline__ void done(const Unit&) const {}
};


__device__ __forceinline__ unsigned cvt_pk_bf16(float lo, float hi) { unsigned r; asm volatile("v_cvt_pk_bf16_f32 %0, %1, %2" : "=v"(r) : "v"(lo), "v"(hi)); return r; }
typedef float f32x2 __attribute__((ext_vector_type(2)));
template <class Epi, class Sched, bool ALIGN_EPI = false, bool SP2 = false, bool HALFN = false, bool BHALF = false, bool KSPLIT = false>
__device__ __forceinline__ void gemm_phase(PG8_LAS unsigned char* lds, const Gemm g, const Sched& S, const Epi& E) {
    const int tid = threadIdx.x, wid = __builtin_amdgcn_readfirstlane(tid >> 6), lane = tid & 63, wr = wid >> 2, wc = wid & 3, fr = lane & 15, fq = lane >> 4;
    const int K = g.K, nt = (KSPLIT ? g.Kloop : K) / BK;
    unsigned voffA[2], voffB[2];
#pragma unroll
    for (int i = 0; i < 2; ++i) { int R, C; stage_rc(tid * 16 + i * 8192, R, C); const int Rb = Epi::PERM ? ((R & ~31) + perm32(R & 31)) : R;
        voffA[i] = (unsigned)(R * K + C) * 2u; voffB[i] = (unsigned)(Rb * K + C) * 2u; }
    const size_t kstep = (size_t)(BK * 2);
    const size_t hstep = (size_t)HALF * K * 2;
    const size_t tstep = 2 * hstep;
    const unsigned ldsw = (unsigned)wid * 1024u;
    const int aoff = lds_byte(wr * 64 + fr, fq * 8), boff = lds_byte(wc * 32 + fr, fq * 8);
#define PG8_SA(b, h) (((b) * 2 + (h)) * HTB)
#define PG8_SB(b, h) ((4 + (b) * 2 + (h)) * HTB)
#define PG8_STAGE(bufoff, gbase, voff) do { _Pragma("unroll") for (int _i = 0; _i < 2; ++_i) \
        __builtin_amdgcn_global_load_lds((const unsigned*)((const char*)(gbase) + (voff)[_i]), (PG8_LAS unsigned*)(lds + (bufoff) + ldsw + _i * 8192), 16, 0, 0); } while (0)
#define PG8_LDA(dst, b, h) do { _Pragma("unroll") for (int m = 0; m < 4; ++m) _Pragma("unroll") for (int k = 0; k < 2; ++k) dst[m][k] = *(const PG8_LAS bf16x8*)(lds + PG8_SA(b, h) + aoff + m * 2048 + k * 1024); } while (0)
#define PG8_LDB(dst, b, h) do { _Pragma("unroll") for (int n = 0; n < 2; ++n) _Pragma("unroll") for (int k = 0; k < 2; ++k) dst[n][k] = *(const PG8_LAS bf16x8*)(lds + PG8_SB(b, h) + boff + n * 2048 + k * 1024); } while (0)
#define PG8_MMA(ai, bj, At, Bt) do { __builtin_amdgcn_s_setprio(1); _Pragma("unroll") for (int m = 0; m < 4; ++m) _Pragma("unroll") for (int n = 0; n < 2; ++n) _Pragma("unroll") for (int k = 0; k < 2; ++k) \
        acc[ai][bj][m][n] = __builtin_amdgcn_mfma_f32_16x16x32_bf16(Bt[n][k], At[m][k], acc[ai][bj][m][n], 0, 0, 0); __builtin_amdgcn_s_setprio(0); } while (0)
#define PG8_WAIT_V(n) asm volatile("s_waitcnt vmcnt(" #n ")" ::: "memory")
#define PG8_WAIT_L(n) asm volatile("s_waitcnt lgkmcnt(" #n ")" ::: "memory")
#define PG8_BAR __builtin_amdgcn_s_barrier()
#define PG8_SCHED __builtin_amdgcn_sched_barrier(0)
    Unit cur, nxt; int ui = 0;
    if (!S.next(0, cur)) return;
    f32x4 acc[2][2][4][2];
#pragma unroll
    for (int a = 0; a < 2; ++a)
#pragma unroll
        for (int b = 0; b < 2; ++b)
#pragma unroll
            for (int m = 0; m < 4; ++m)
#pragma unroll
                for (int n = 0; n < 2; ++n) acc[a][b][m][n] = (f32x4){0.f, 0.f, 0.f, 0.f};
    bf16x8 At[4][2], B0[2][2], B1[2][2];
    const char* cA = (const char*)g.A + (size_t)cur.pm * tstep + (KSPLIT ? (size_t)cur.kc * g.Kloop * 2 : 0); const char* cB = (const char*)g.Bt + (size_t)cur.pn * (BHALF ? hstep : tstep) + (KSPLIT ? (size_t)cur.kc * g.Kloop * 2 : 0);
    S.a_ready(cur);
    if constexpr (SP2) {
        PG8_STAGE(PG8_SB(0, 0), cB, voffB); PG8_STAGE(PG8_SB(0, 1), cB + hstep, voffB); PG8_STAGE(PG8_SA(0, 0), cA, voffA); PG8_STAGE(PG8_SA(0, 1), cA + hstep, voffA);
        if (wr == 1) PG8_BAR;
        PG8_WAIT_V(2); PG8_BAR;
        PG8_STAGE(PG8_SB(1, 0), cB + kstep, voffB); PG8_STAGE(PG8_SA(1, 0), cA + kstep, voffA); PG8_STAGE(PG8_SB(1, 1), cB + hstep + kstep, voffB);
        PG8_WAIT_V(6); PG8_BAR;
    } else {
        PG8_STAGE(PG8_SB(0, 0), cB, voffB); PG8_STAGE(PG8_SA(0, 0), cA, voffA); PG8_STAGE(PG8_SB(0, 1), cB + hstep, voffB); PG8_STAGE(PG8_SA(0, 1), cA + hstep, voffA);
        if (wr == 1) PG8_BAR;
        PG8_WAIT_V(4); PG8_BAR;
        PG8_STAGE(PG8_SB(1, 0), cB + kstep, voffB); PG8_STAGE(PG8_SA(1, 0), cA + kstep, voffA); PG8_STAGE(PG8_SB(1, 1), cB + hstep + kstep, voffB);
        PG8_WAIT_V(6); PG8_BAR;
    }
    for (;;) {
        const bool has_next = S.next(ui + 1, nxt);
        const char* nA = has_next ? (const char*)g.A + (size_t)nxt.pm * tstep + (KSPLIT ? (size_t)nxt.kc * g.Kloop * 2 : 0) : cA; const char* nB = has_next ? (const char*)g.Bt + (size_t)nxt.pn * (BHALF ? hstep : tstep) + (KSPLIT ? (size_t)nxt.kc * g.Kloop * 2 : 0) : cB;
        for (int t = 0; t < nt; t += 2) {
            const bool last = (t == nt - 2);
            const char* a1 = cA + (size_t)(t + 1) * kstep;
            const char* a2 = last ? nA : cA + (size_t)(t + 2) * kstep; const char* b2 = last ? nB : cB + (size_t)(t + 2) * kstep;
            const char* a3 = a2 + kstep; const char* b3 = b2 + kstep;
            if (last && has_next) S.a_ready(nxt);
            if constexpr (SP2) {
            PG8_LDB(B0, 0, 0); PG8_LDB(B1, 0, 1); PG8_SCHED; PG8_LDA(At, 0, 0); PG8_STAGE(PG8_SA(1, 1), a1 + hstep, voffA);
            PG8_WAIT_V(8); PG8_WAIT_L(0); PG8_BAR; PG8_MMA(0, 0, At, B0); if constexpr (!HALFN) { PG8_MMA(0, 1, At, B1); } PG8_BAR; PG8_SCHED;
            PG8_LDA(At, 0, 1); PG8_STAGE(PG8_SB(0, 0), b2, voffB); PG8_STAGE(PG8_SB(0, 1), b2 + hstep, voffB); PG8_STAGE(PG8_SA(0, 0), a2, voffA);
            PG8_WAIT_V(8); PG8_WAIT_L(0); PG8_BAR; PG8_MMA(1, 0, At, B0); if constexpr (!HALFN) { PG8_MMA(1, 1, At, B1); } PG8_BAR; PG8_SCHED;
            PG8_LDB(B0, 1, 0); PG8_LDB(B1, 1, 1); PG8_SCHED; PG8_LDA(At, 1, 0); PG8_STAGE(PG8_SA(0, 1), a2 + hstep, voffA);
            PG8_WAIT_V(8); PG8_WAIT_L(0); PG8_BAR; PG8_MMA(0, 0, At, B0); if constexpr (!HALFN) { PG8_MMA(0, 1, At, B1); } PG8_BAR; PG8_SCHED;
            PG8_LDA(At, 1, 1); PG8_STAGE(PG8_SB(1, 0), b3, voffB); PG8_STAGE(PG8_SB(1, 1), b3 + hstep, voffB); PG8_STAGE(PG8_SA(1, 0), a3, voffA);
            PG8_WAIT_V(8); PG8_WAIT_L(0); PG8_BAR; PG8_MMA(1, 0, At, B0); if constexpr (!HALFN) { PG8_MMA(1, 1, At, B1); } PG8_BAR; PG8_SCHED;
            } else {
            PG8_LDB(B0, 0, 0); PG8_SCHED; PG8_LDA(At, 0, 0); PG8_STAGE(PG8_SA(1, 1), a1 + hstep, voffA);
            PG8_WAIT_L(8); PG8_BAR; PG8_WAIT_L(0); PG8_MMA(0, 0, At, B0); PG8_BAR; PG8_SCHED;
            PG8_LDB(B1, 0, 1); PG8_STAGE(PG8_SB(0, 0), b2, voffB);
            PG8_BAR; PG8_WAIT_L(0); PG8_MMA(0, 1, At, B1); PG8_BAR;
            PG8_LDA(At, 0, 1); PG8_STAGE(PG8_SA(0, 0), a2, voffA);
            PG8_BAR; PG8_WAIT_L(0); PG8_MMA(1, 0, At, B0); PG8_BAR; PG8_SCHED;
            PG8_STAGE(PG8_SB(0, 1), b2 + hstep, voffB);
            PG8_WAIT_V(6); PG8_BAR; PG8_MMA(1, 1, At, B1); PG8_BAR;
            PG8_LDB(B0, 1, 0); PG8_SCHED; PG8_LDA(At, 1, 0); PG8_STAGE(PG8_SA(0, 1), a2 + hstep, voffA);
            PG8_WAIT_L(8); PG8_BAR; PG8_WAIT_L(0); PG8_MMA(0, 0, At, B0); PG8_BAR; PG8_SCHED;
            PG8_LDB(B1, 1, 1); PG8_STAGE(PG8_SB(1, 0), b3, voffB);
            PG8_BAR; PG8_WAIT_L(0); PG8_MMA(0, 1, At, B1); PG8_BAR;
            PG8_LDA(At, 1, 1); PG8_STAGE(PG8_SA(1, 0), a3, voffA);
            PG8_BAR; PG8_WAIT_L(0); PG8_MMA(1, 0, At, B0); PG8_BAR; PG8_SCHED;
            PG8_STAGE(PG8_SB(1, 1), b3 + hstep, voffB);
            PG8_WAIT_V(6); PG8_BAR; PG8_MMA(1, 1, At, B1); PG8_BAR;
            }
        }
        if constexpr (ALIGN_EPI) { if (wr == 0) PG8_BAR; }
        if constexpr (!Epi::AFTER_DRAIN) { E(acc, cur, wr, wc, fr, fq); S.done(cur); }
        if (!has_next) break;
#pragma unroll
        for (int a = 0; a < 2; ++a)
#pragma unroll
            for (int b = 0; b < 2; ++b)
#pragma unroll
                for (int m = 0; m < 4; ++m)
#pragma unroll
                    for (int n = 0; n < 2; ++n) acc[a][b][m][n] = (f32x4){0.f, 0.f, 0.f, 0.f};
        cur = nxt; cA = nA; cB = nB; ++ui;
        if constexpr (ALIGN_EPI) { if (wr == 1) PG8_BAR; }
    }
    PG8_WAIT_V(0);
    if constexpr (!ALIGN_EPI) { if (wr == 0) PG8_BAR; }
    PG8_BAR;
    if constexpr (Epi::AFTER_DRAIN) { E.fused(acc, cur, wr, wc, fr, fq, lds, wid, lane); S.done(cur); }
#undef PG8_SA
#undef PG8_SB
#undef PG8_STAGE
#undef PG8_LDA
#undef PG8_LDB
#undef PG8_MMA
#undef PG8_WAIT_V
#undef PG8_WAIT_L
#undef PG8_BAR
#undef PG8_SCHED
}
}
#define LAS __attribute__((address_space(3)))
#define XB_TMO      128
#define XB_XCNT(j)  (256  + 64 * (j))
#define XB_XSUB(j)  (1280 + 64 * (j))
#define XB_XGEN(j)  (2304 + 64 * (j))
#define XB_TOP      3328
#define XB_TOPGEN   3392
#define XCD_BAR_WORDS 3456
#define XB_SPIN_CAP (1u << 18)

__device__ __forceinline__ unsigned xb_ld(unsigned* p)              { return __hip_atomic_load(p, __ATOMIC_RELAXED, __HIP_MEMORY_SCOPE_AGENT); }
__device__ __forceinline__ unsigned xb_add(unsigned* p, unsigned v) { return __hip_atomic_fetch_add(p, v, __ATOMIC_RELAXED, __HIP_MEMORY_SCOPE_AGENT); }
__device__ __forceinline__ unsigned xb_xcc_id() { return (unsigned)__builtin_amdgcn_s_getreg((3 << 11) | 20) & 0xFu; }
#define XB_SPIN(cond, bar) do { unsigned _sp = 0; while (cond) { __builtin_amdgcn_s_sleep(1); \
    if ((++_sp & 255u) == 0u) { if (xb_ld(&(bar)[XB_TMO])) break; if (_sp > XB_SPIN_CAP) { atomicAdd(&(bar)[XB_TMO], 1u); break; } } } } while (0)

struct XcdBarrier {
    unsigned* bar; unsigned x;
    volatile LAS unsigned* st;
};

__device__ __forceinline__ XcdBarrier xcd_barrier_post(unsigned* bar, volatile LAS unsigned* st) {
    XcdBarrier b; b.bar = bar; b.x = xb_xcc_id(); b.st = st;
    if (threadIdx.x == 0) (void)xb_add(&bar[XB_XCNT(b.x)], 1u);
    return b;
}
__device__ __forceinline__ void xcd_barrier_complete(unsigned* bar, unsigned x, unsigned& nloc, unsigned& nx) {
    const unsigned G = gridDim.x * gridDim.y * gridDim.z;
    unsigned sum, cnt, mine, sp = 0u;
    for (;;) {
        sum = 0u; cnt = 0u; mine = 0u;
#pragma unroll
        for (unsigned j = 0; j < 16; ++j) { const unsigned c = xb_ld(&bar[XB_XCNT(j)]); sum += c; cnt += (c > 0u) ? 1u : 0u; mine = (j == x) ? c : mine; }
        if (sum == G) break;
        __builtin_amdgcn_s_sleep(1);
        if ((++sp & 255u) == 0u) { if (xb_ld(&bar[XB_TMO])) break; if (sp > XB_SPIN_CAP) { atomicAdd(&bar[XB_TMO], 1u); break; } }
    }
    nloc = mine > 0u ? mine : 1u; nx = cnt > 0u ? cnt : 1u;
}

__device__ __forceinline__ void xcd_barrier(const XcdBarrier& b) {
    asm volatile("s_waitcnt vmcnt(0)" ::: "memory");
    __syncthreads();
    if (threadIdx.x == 0) {
        unsigned* bar = b.bar;
        __builtin_amdgcn_s_waitcnt(0);
        unsigned nloc = b.st[0], nx = b.st[1];
        if (nloc == 0u) { xcd_barrier_complete(bar, b.x, nloc, nx); b.st[0] = nloc; b.st[1] = nx; }
        const unsigned old = xb_add(&bar[XB_XSUB(b.x)], 1u);
        const unsigned gen = old / nloc;
        if (old + 1u == (gen + 1u) * nloc) {
            __builtin_amdgcn_fence(__ATOMIC_RELEASE, "agent");
            asm volatile("s_waitcnt vmcnt(0)" ::: "memory");
            const unsigned og = xb_add(&bar[XB_TOP], 1u);
            const unsigned tg = og / nx;
            if (og + 1u == (tg + 1u) * nx) xb_add(&bar[XB_TOPGEN], 1u);
            else XB_SPIN(xb_ld(&bar[XB_TOPGEN]) == tg, bar);
            __builtin_amdgcn_fence(__ATOMIC_ACQUIRE, "agent");
            xb_add(&bar[XB_XGEN(b.x)], 1u);
            asm volatile("s_waitcnt vmcnt(0)" ::: "memory");
        } else {
            XB_SPIN(xb_ld(&bar[XB_XGEN(b.x)]) == gen, bar);
            __builtin_amdgcn_fence(__ATOMIC_ACQUIRE, "agent");
            asm volatile("s_waitcnt vmcnt(0)" ::: "memory");
        }
    }
    __syncthreads();
}
#undef LAS

constexpr int DM = 1024, NB = 8, SEQ = 4096, DBATCH = 32, DSEQ = 8, PAST = 16384, PAGE = 128, NPAGES = PAST / PAGE;
constexpr int MP = NB * SEQ, MS = DBATCH * DSEQ, MT = MP + MS;
constexpr int NIN0 = 2048;
constexpr int NSA_IN = 1828, DFF = 2816, NUP = 2 * DFF, NMEM = 256;
constexpr int CMP_ROWS_P = NB * 64 * 2, CMP_ROWS_S = DBATCH * 256 * 2, CMP_ROWS = CMP_ROWS_P + CMP_ROWS_S;
constexpr float EPS = 1e-6f, QSCALE_ = 0.125f * 1.4426950408889634f;
constexpr size_t O_YP = 0, O_YS = O_YP + (size_t)MP * DM, O_KVP = O_YS + (size_t)MS * DM, O_KVS = O_KVP + (size_t)MP * 512, O_WINP = O_KVS + (size_t)MS * 512,
                 O_WINS = O_WINP + (size_t)NB * 512 * 256, O_MKV = O_WINS + (size_t)DBATCH * 512 * 256, O_POOLP = O_MKV + (size_t)2 * NB * NMEM * 512,
                 O_POOLS = O_POOLP + (size_t)NB * 15 * 768, O_CONVP = O_POOLS + (size_t)DBATCH * 15 * 768, O_CONVS = O_CONVP + (size_t)2 * NB * 2 * NUP,
                 O_END = O_CONVS + (size_t)2 * DBATCH * 2 * NUP;
static_assert(O_END == 59426816, "output size");
enum { I_XP = 0, I_XS, I_CKV, I_CWIN, I_CMEM, I_SPOOL, I_SCONV, I_PT, I_MEMP, I_RELB, I_GMIX, I_GMEM, I_GFFN, I_WINNSA, I_QG, I_KG, I_CPOS, I_CW1, I_CB1, I_CW2, I_CB2,
       I_WINPOOL, I_WPG, I_PSCALE, I_WMEMKV, I_XQG, I_XKG, I_WOUT, I_WUP, I_CONVW, I_CONVB, I_WDOWN, N_IN };
constexpr size_t MiB = 1u << 20;
constexpr size_t WS_CTL = 0, CTL_ZERO_BYTES = 1 * MiB;
constexpr size_t WS_WIN0 = 4 * MiB, WS_WIN1 = 8 * MiB, WS_WMEM = 10 * MiB, WS_WOUT = 12 * MiB, WS_WUP = 16 * MiB, WS_WDOWN = 38 * MiB, WS_WC1 = 49 * MiB, WS_SSQ0 = 51 * MiB,
                 WS_MEMN = 52 * MiB, WS_KC = 56 * MiB, WS_H1 = 66 * MiB, WS_XB = 84 * MiB, WS_Q = 150 * MiB, WS_XQ = 248 * MiB, WS_G = 282 * MiB, WS_WINP = 292 * MiB,
                 WS_CMPA = 324 * MiB, WS_MIX = 596 * MiB, WS_Y1 = 662 * MiB, WS_Y1B = 792 * MiB, WS_U = 858 * MiB, WS_ACT = 1214 * MiB, WS_Y2 = 1392 * MiB, WS_Y2B = 1522 * MiB,
                 WS_UP = 1588 * MiB, WS_Y3 = 1686 * MiB, WS_Y3B = 1816 * MiB, WS_QB = 1882 * MiB, WS_XQB = 1930 * MiB, WS_KSB = 1946 * MiB, WS_VST = 1954 * MiB,
                 WS_KWB = 1962 * MiB, WS_VWT = 1970 * MiB, WS_KCB = 1978 * MiB, WS_VCT = 1979 * MiB, WS_MKB = 1980 * MiB, WS_MVT = 1982 * MiB, WS_UB = 1984 * MiB, WS_US = 1996 * MiB, WS_WC1B = 2002 * MiB, WS_H1N = 2006 * MiB, WS_END = 2024 * MiB;
static_assert(WS_WUP + (size_t)2 * NUP * DM * 2 <= WS_WDOWN && WS_WDOWN + (size_t)2 * DM * DFF * 2 <= WS_WC1 && WS_KC + (size_t)2 * CMP_ROWS * 64 * 4 <= WS_H1 &&
              WS_H1 + (size_t)2 * CMP_ROWS * 128 * 4 <= WS_XB && WS_XB + (size_t)MT * DM * 2 <= WS_Q && WS_Q + (size_t)MT * 768 * 4 <= WS_XQ && WS_XQ + (size_t)MT * 256 * 4 <= WS_G &&
              WS_G + (size_t)MT * 64 * 4 <= WS_WINP && WS_WINP + (size_t)MP * 256 * 4 <= WS_CMPA && WS_CMPA + (size_t)2 * CMP_ROWS * 4096 * 2 <= WS_MIX &&
              WS_MIX + (size_t)MT * DM * 2 <= WS_Y1 && WS_Y1 + (size_t)MT * DM * 4 <= WS_Y1B && WS_Y1B + (size_t)MT * DM * 2 <= WS_U && WS_U + (size_t)MT * NUP * 2 <= WS_ACT &&
              WS_ACT + (size_t)MT * DFF * 2 <= WS_Y2 && WS_Y2 + (size_t)MT * DM * 4 <= WS_Y2B && WS_Y2B + (size_t)MT * DM * 2 <= WS_UP && WS_UP + (size_t)MT * 768 * 4 <= WS_Y3 &&
              WS_Y3 + (size_t)MT * DM * 4 <= WS_Y3B && WS_Y3B + (size_t)MT * DM * 2 <= WS_QB && WS_QB + (size_t)MP * 768 * 2 <= WS_XQB && WS_XQB + (size_t)MP * 256 * 2 <= WS_KSB, "d_ws map");
constexpr int CW_TMO = 0, CW_BAR = 4096, CW_SSQ = 16384, SSQ_STRIDE = 34816, CW_B1EFF = 131072;
static_assert(CW_SSQ + 3 * SSQ_STRIDE <= CW_B1EFF && (CW_B1EFF + 256) * 4 <= (int)CTL_ZERO_BYTES, "ctl map");
constexpr int RING_OFF = 0, RING_BYTES = 131072, LDSCTL_OFF = RING_BYTES, MISC_OFF = LDSCTL_OFF + 320, LDS_BYTES = 147456;
constexpr int NWAVES = 8;

#define GAS __attribute__((address_space(1)))
#define LAS __attribute__((address_space(3)))
typedef unsigned short bf16;
typedef unsigned v4u __attribute__((ext_vector_type(4)));
typedef unsigned v2u __attribute__((ext_vector_type(2)));
typedef float f32x4 __attribute__((ext_vector_type(4)));
#define LDS_WAIT() asm volatile("s_waitcnt lgkmcnt(0)" ::: "memory")
using pg8::cvt_pk_bf16;

__device__ __forceinline__ float wave_sum(float v) {
    v += __builtin_bit_cast(float, __builtin_amdgcn_mov_dpp(__builtin_bit_cast(int, v), 0x128, 0xf, 0xf, false));
    v += __builtin_bit_cast(float, __builtin_amdgcn_mov_dpp(__builtin_bit_cast(int, v), 0x124, 0xf, 0xf, false));
    v += __builtin_bit_cast(float, __builtin_amdgcn_mov_dpp(__builtin_bit_cast(int, v), 0x122, 0xf, 0xf, false));
    v += __builtin_bit_cast(float, __builtin_amdgcn_mov_dpp(__builtin_bit_cast(int, v), 0x121, 0xf, 0xf, false));
    const int vi = __builtin_bit_cast(int, v);
    return (__builtin_bit_cast(float, __builtin_amdgcn_readlane(vi, 0)) + __builtin_bit_cast(float, __builtin_amdgcn_readlane(vi, 16))) + (__builtin_bit_cast(float, __builtin_amdgcn_readlane(vi, 32)) + __builtin_bit_cast(float, __builtin_amdgcn_readlane(vi, 48)));
}
__device__ __forceinline__ float wave_max(float v) {
#pragma unroll
    for (int o = 1; o < 64; o <<= 1) v = fmaxf(v, __shfl_xor(v, o));
    return v;
}
__device__ __forceinline__ float fq_sum(float x) {
    int l_ = (int)__builtin_amdgcn_mbcnt_hi(~0u, __builtin_amdgcn_mbcnt_lo(~0u, 0u)); asm volatile("" : "+v"(l_));
    x += __builtin_bit_cast(float, __builtin_amdgcn_ds_bpermute((l_ ^ 16) << 2, __builtin_bit_cast(int, x)));
    x += __builtin_bit_cast(float, __builtin_amdgcn_ds_bpermute((l_ ^ 32) << 2, __builtin_bit_cast(int, x)));
    return x;
}
__device__ __forceinline__ float bf2f(unsigned short h) { return __uint_as_float((unsigned)h << 16); }
__device__ __forceinline__ float sigmoidf_(float x) { return 1.0f / (1.0f + __expf(-x)); }
__device__ __forceinline__ float gelu_tanh(float x) { const float y = 0.7978845608028654f * (x + 0.044715f * x * x * x); const float t = 1.0f - 2.0f / (__expf(2.0f * y) + 1.0f); return 0.5f * x * (1.0f + t); }

using pg8::Unit;
#define EPI_ROW(u, ai, wr, m, fr) ((u).pm * 256 + (ai) * 128 + (wr) * 64 + (m) * 16 + (fr))

constexpr int LDS_VTT = LDSCTL_OFF + 1024;
struct EpiInNsa {
    static constexpr bool PERM = true, AFTER_DRAIN = false;
    const float* ssq0; const float* qgain; const float* kgain; const float* xqgain;
    float* Qf; float* XQf; float* Gf; float* out; bf16* Qb; bf16* XQb; bf16* KSb; bf16* VSt; bf16* KWb; bf16* VWt; LAS unsigned char* lds;
    __device__ __forceinline__ void operator()(const f32x4 (&acc)[2][2][4][2], const Unit& u, int wr, int wc, int fr_in, int fq_in) const {
        int lane_ = fr_in + 16 * fq_in; asm volatile("" : "+v"(lane_)); const int fr = lane_ & 15, fq = lane_ >> 4;
        const int pn = u.pn;
        float sq8[2][4];
#pragma unroll
        for (int ai = 0; ai < 2; ++ai)
#pragma unroll
            for (int m = 0; m < 4; ++m) sq8[ai][m] = ssq0[EPI_ROW(u, ai, wr, m, fr)];
        __builtin_amdgcn_sched_barrier(0);
#pragma unroll
        for (int ai = 0; ai < 2; ++ai)
#pragma unroll
            for (int m = 0; m < 4; ++m) {
                const int row = EPI_ROW(u, ai, wr, m, fr);
                const float rstd = rsqrtf(sq8[ai][m] * (1.0f / DM) + EPS);
                float v[16]; float ss = 0.f;
#pragma unroll
                for (int bj = 0; bj < 2; ++bj)
#pragma unroll
                    for (int n = 0; n < 2; ++n)
#pragma unroll
                        for (int e = 0; e < 4; ++e) { const float x = acc[ai][bj][m][n][e] * rstd; v[bj * 8 + n * 4 + e] = x; ss += x * x; }
                ss = fq_sum(ss);
                const float hn = rsqrtf(ss * (1.0f / 64.0f) + EPS);
                const bool samp = row >= MP; const int rs = row - MP;
                if (pn < 3) {
                    const int h = 4 * pn + wc;
#pragma unroll
                    for (int bj = 0; bj < 2; ++bj) { const int d0 = 32 * bj + 8 * fq;
                        const f32x4 g0 = *(const f32x4*)(qgain + d0), g1 = *(const f32x4*)(qgain + d0 + 4);
                        const f32x4 a = (f32x4){v[bj * 8 + 0] * hn * g0[0], v[bj * 8 + 1] * hn * g0[1], v[bj * 8 + 2] * hn * g0[2], v[bj * 8 + 3] * hn * g0[3]};
                        const f32x4 b = (f32x4){v[bj * 8 + 4] * hn * g1[0], v[bj * 8 + 5] * hn * g1[1], v[bj * 8 + 6] * hn * g1[2], v[bj * 8 + 7] * hn * g1[3]};
                        if (samp) { float* dst = Qf + (size_t)row * 768 + h * 64 + d0; *(f32x4*)dst = a; *(f32x4*)(dst + 4) = b; }
                        else { v4u w; w.x = cvt_pk_bf16(a[0] * QSCALE_, a[1] * QSCALE_); w.y = cvt_pk_bf16(a[2] * QSCALE_, a[3] * QSCALE_); w.z = cvt_pk_bf16(b[0] * QSCALE_, b[1] * QSCALE_); w.w = cvt_pk_bf16(b[2] * QSCALE_, b[3] * QSCALE_);
                            *(v4u*)(Qb + (size_t)row * 768 + h * 64 + d0) = w; } }
                } else if (pn < 6) {
                    const int gidx = 4 * (pn - 3) + wc, i = gidx >> 1, g = gidx & 1; const bool nrm = (i == 2) || (i == 4);
#pragma unroll
                    for (int bj = 0; bj < 2; ++bj) { const int d0 = 32 * bj + 8 * fq; float o8[8];
                        const f32x4 kg0 = *(const f32x4*)(kgain + d0), kg1 = *(const f32x4*)(kgain + d0 + 4);
#pragma unroll
                        for (int e = 0; e < 8; ++e) { const float gk_ = e < 4 ? kg0[e & 3] : kg1[e & 3]; o8[e] = nrm ? v[bj * 8 + e] * hn * gk_ : v[bj * 8 + e]; }
                        const f32x4 a = (f32x4){o8[0], o8[1], o8[2], o8[3]}, b = (f32x4){o8[4], o8[5], o8[6], o8[7]};
                        if (i < 4) {
                            float* dst = samp ? out + O_KVS + ((size_t)rs * 4 + i) * 128 + g * 64 + d0 : out + O_KVP + ((size_t)row * 4 + i) * 128 + g * 64 + d0;
                            *(f32x4*)dst = a; *(f32x4*)(dst + 4) = b;
                        } else {
                            if (samp) { const int b_ = rs >> 3, t = rs & 7; float* dst = out + O_WINS + (((size_t)b_ * 512 + 504 + t) * 2 + (i - 4)) * 128 + g * 64 + d0; *(f32x4*)dst = a; *(f32x4*)(dst + 4) = b; }
                            else { const int b_ = row >> 12, t = row & 4095;
                                if (t >= SEQ - 512) { float* d2 = out + O_WINP + (((size_t)b_ * 512 + (t - (SEQ - 512))) * 2 + (i - 4)) * 128 + g * 64 + d0; *(f32x4*)d2 = a; *(f32x4*)(d2 + 4) = b; } }
                        }
                        if (!samp && i >= 2) {
                            const int b_ = row >> 12, t = row & 4095, bg = b_ * 2 + g;
                            if ((i & 1) == 0) { v4u w; w.x = cvt_pk_bf16(o8[0], o8[1]); w.y = cvt_pk_bf16(o8[2], o8[3]); w.z = cvt_pk_bf16(o8[4], o8[5]); w.w = cvt_pk_bf16(o8[6], o8[7]);
                                *(v4u*)((i == 2 ? KSb : KWb) + ((size_t)bg * SEQ + t) * 64 + d0) = w; }
                            else {
                                LAS bf16* vl = (LAS bf16*)(lds + LDS_VTT + (wr * 2 + (wc & 1)) * 2048) + d0 * 16 + fr;
#pragma unroll
                                for (int e = 0; e < 8; ++e) vl[e * 16] = (bf16)(cvt_pk_bf16(o8[e], 0.f) & 0xffffu); }
                        }
                    }
                    if (!samp && (i == 3 || i == 5)) {
                        asm volatile("s_waitcnt lgkmcnt(0)" ::: "memory");
                        const LAS v4u* vr = (const LAS v4u*)(lds + LDS_VTT + (wr * 2 + (wc & 1)) * 2048 + lane_ * 32);
                        const v4u x0 = vr[0], x1 = vr[1];
                        const int r0 = row - fr, bg = (r0 >> 12) * 2 + g;
                        bf16* vt = (i == 3 ? VSt : VWt) + ((size_t)bg * 64 + lane_) * SEQ + (r0 & 4095);
                        *(v4u*)vt = x0; *(v4u*)(vt + 8) = x1;
                        asm volatile("s_waitcnt lgkmcnt(0)" ::: "memory");
                    }
                } else if (pn == 6) {
#pragma unroll
                    for (int bj = 0; bj < 2; ++bj) { const int d0 = 32 * bj + 8 * fq;
                        const f32x4 g0 = *(const f32x4*)(xqgain + d0), g1 = *(const f32x4*)(xqgain + d0 + 4);
                        const f32x4 a = (f32x4){v[bj * 8 + 0] * hn * g0[0], v[bj * 8 + 1] * hn * g0[1], v[bj * 8 + 2] * hn * g0[2], v[bj * 8 + 3] * hn * g0[3]};
                        const f32x4 b = (f32x4){v[bj * 8 + 4] * hn * g1[0], v[bj * 8 + 5] * hn * g1[1], v[bj * 8 + 6] * hn * g1[2], v[bj * 8 + 7] * hn * g1[3]};
                        if (samp) { float* dst = XQf + (size_t)row * 256 + wc * 64 + d0; *(f32x4*)dst = a; *(f32x4*)(dst + 4) = b; }
                        else { v4u w; w.x = cvt_pk_bf16(a[0] * QSCALE_, a[1] * QSCALE_); w.y = cvt_pk_bf16(a[2] * QSCALE_, a[3] * QSCALE_); w.z = cvt_pk_bf16(b[0] * QSCALE_, b[1] * QSCALE_); w.w = cvt_pk_bf16(b[2] * QSCALE_, b[3] * QSCALE_);
                            *(v4u*)(XQb + (size_t)row * 256 + wc * 64 + d0) = w; } }
                } else {
                    if (wc == 0) {
#pragma unroll
                        for (int bj = 0; bj < 2; ++bj) { const int d0 = 32 * bj + 8 * fq; float* dst = Gf + (size_t)row * 64 + d0;
                            *(f32x4*)dst = (f32x4){sigmoidf_(v[bj * 8 + 0]), sigmoidf_(v[bj * 8 + 1]), sigmoidf_(v[bj * 8 + 2]), sigmoidf_(v[bj * 8 + 3])};
                            *(f32x4*)(dst + 4) = (f32x4){sigmoidf_(v[bj * 8 + 4]), sigmoidf_(v[bj * 8 + 5]), sigmoidf_(v[bj * 8 + 6]), sigmoidf_(v[bj * 8 + 7])}; }
                    }
                }
            }
    }
};

struct EpiMemKV {
    static constexpr bool PERM = true, AFTER_DRAIN = false;
    const float* xkgain; float* out; bf16* MKb; bf16* MVt;
    __device__ __forceinline__ void operator()(const f32x4 (&acc)[2][2][4][2], const Unit& u, int wr, int wc, int fr_in, int fq_in) const {
        int lane_ = fr_in + 16 * fq_in; asm volatile("" : "+v"(lane_)); const int fr = lane_ & 15, fq = lane_ >> 4;
        const int layer = u.pn >> 1, kv = u.pn & 1;
#pragma unroll
        for (int ai = 0; ai < 2; ++ai)
#pragma unroll
            for (int m = 0; m < 4; ++m) {
                const int row = EPI_ROW(u, ai, wr, m, fr);
                float v[16]; float ss = 0.f;
#pragma unroll
                for (int bj = 0; bj < 2; ++bj)
#pragma unroll
                    for (int n = 0; n < 2; ++n)
#pragma unroll
                        for (int e = 0; e < 4; ++e) { const float x = acc[ai][bj][m][n][e]; v[bj * 8 + n * 4 + e] = x; ss += x * x; }
                ss = fq_sum(ss);
                const float hn = rsqrtf(ss * (1.0f / 64.0f) + EPS);
#pragma unroll
                for (int bj = 0; bj < 2; ++bj) { const int d0 = 32 * bj + 8 * fq; float o8[8];
                    const f32x4 kg0 = *(const f32x4*)(xkgain + layer * 64 + d0), kg1 = *(const f32x4*)(xkgain + layer * 64 + d0 + 4);
#pragma unroll
                    for (int e = 0; e < 8; ++e) { const float gk_ = e < 4 ? kg0[e & 3] : kg1[e & 3]; o8[e] = (kv == 0) ? v[bj * 8 + e] * hn * gk_ : v[bj * 8 + e]; }
                    float* dst = out + O_MKV + (((size_t)layer * NB * NMEM + row) * 2 + kv) * 256 + wc * 64 + d0;
                    *(f32x4*)dst = (f32x4){o8[0], o8[1], o8[2], o8[3]}; *(f32x4*)(dst + 4) = (f32x4){o8[4], o8[5], o8[6], o8[7]};
                    const int bh = (layer * 32 + (row >> 8) * 4 + wc), mtok = row & 255;
                    if (kv == 0) { v4u w; w.x = cvt_pk_bf16(o8[0], o8[1]); w.y = cvt_pk_bf16(o8[2], o8[3]); w.z = cvt_pk_bf16(o8[4], o8[5]); w.w = cvt_pk_bf16(o8[6], o8[7]); *(v4u*)(MKb + ((size_t)bh * NMEM + mtok) * 64 + d0) = w; }
                    else { bf16* vt = MVt + ((size_t)bh * 64 + d0) * NMEM + mtok;
#pragma unroll
                        for (int e = 0; e < 8; ++e) vt[(size_t)e * NMEM] = (bf16)(cvt_pk_bf16(o8[e], 0.f) & 0xffffu); } }
            }
    }
};

struct EpiCmp1 {
    static constexpr bool PERM = true, AFTER_DRAIN = false;
    int which; const float* b1; const float* b1eff; float* H1;
    __device__ __forceinline__ void operator()(const f32x4 (&acc)[2][2][4][2], const Unit& u, int wr, int wc, int fr_in, int fq_in) const {
        int lane_ = fr_in + 16 * fq_in; asm volatile("" : "+v"(lane_)); const int fr = lane_ & 15, fq = lane_ >> 4;
        const int n0 = 32 * wc + 8 * fq; float bb[8];
#pragma unroll
        for (int e = 0; e < 8; ++e) bb[e] = b1[which * 128 + n0 + e] + b1eff[which * 128 + n0 + e];
#pragma unroll
        for (int ai = 0; ai < 2; ++ai)
#pragma unroll
            for (int m = 0; m < 4; ++m) {
                const int row = EPI_ROW(u, ai, wr, m, fr);
                float* dst = H1 + ((size_t)which * CMP_ROWS + row) * 128 + n0;
                f32x4 a, b;
#pragma unroll
                for (int e = 0; e < 4; ++e) { a[e] = gelu_tanh(acc[ai][0][m][0][e] + bb[e]); b[e] = gelu_tanh(acc[ai][0][m][1][e] + bb[4 + e]); }
                *(f32x4*)dst = a; *(f32x4*)(dst + 4) = b;
            }
    }
};

template <bool HALF>
struct EpiResidT {
    static constexpr bool PERM = true, AFTER_DRAIN = false;
    const bf16* baseB; float* outF; bf16* outB; float* ssq;
    __device__ __forceinline__ void operator()(const f32x4 (&acc)[2][2][4][2], const Unit& u, int wr, int wc, int fr_in, int fq_in) const {
        int lane_ = fr_in + 16 * fq_in; asm volatile("" : "+v"(lane_)); const int fr = lane_ & 15, fq = lane_ >> 4;
#pragma unroll
        for (int ai = 0; ai < 2; ++ai) {
          v4u bs[4][HALF ? 1 : 2];
#pragma unroll
          for (int m = 0; m < 4; ++m) { const int row = EPI_ROW(u, ai, wr, m, fr);
#pragma unroll
              for (int bj = 0; bj < (HALF ? 1 : 2); ++bj) { const int c0 = (HALF ? u.pn * 128 : u.pn * 256 + bj * 128) + wc * 32 + 8 * fq; bs[m][bj] = *(const v4u*)((const char*)baseB + (unsigned)(row * DM + c0) * 2u); } }
          __builtin_amdgcn_sched_barrier(0);
#pragma unroll
            for (int m = 0; m < 4; ++m) {
                const int row = EPI_ROW(u, ai, wr, m, fr);
                float ss = 0.f;
#pragma unroll
                for (int bj = 0; bj < (HALF ? 1 : 2); ++bj) { const int c0 = (HALF ? u.pn * 128 : u.pn * 256 + bj * 128) + wc * 32 + 8 * fq;
                    const v4u bw = bs[m][bj];
                    const f32x4 b0 = (f32x4){__uint_as_float(bw.x << 16), __uint_as_float(bw.x & 0xffff0000u), __uint_as_float(bw.y << 16), __uint_as_float(bw.y & 0xffff0000u)};
                    const f32x4 b1 = (f32x4){__uint_as_float(bw.z << 16), __uint_as_float(bw.z & 0xffff0000u), __uint_as_float(bw.w << 16), __uint_as_float(bw.w & 0xffff0000u)};
                    const f32x4 y0 = b0 + acc[ai][bj][m][0], y1 = b1 + acc[ai][bj][m][1];
                    if (outF) { *(f32x4*)(outF + (size_t)row * DM + c0) = y0; *(f32x4*)(outF + (size_t)row * DM + c0 + 4) = y1; }
                    if (outB) { v4u w; w.x = cvt_pk_bf16(y0[0], y0[1]); w.y = cvt_pk_bf16(y0[2], y0[3]); w.z = cvt_pk_bf16(y1[0], y1[1]); w.w = cvt_pk_bf16(y1[2], y1[3]);
                        *(v4u*)((char*)outB + (unsigned)(row * DM + c0) * 2u) = w;
                        ss += (y0[0] * y0[0] + y0[1] * y0[1]) + (y0[2] * y0[2] + y0[3] * y0[3]) + (y1[0] * y1[0] + y1[1] * y1[1]) + (y1[2] * y1[2] + y1[3] * y1[3]); } }
                if (outB) { ss = fq_sum(ss); if (fq == 0) atomicAdd(ssq + row, ss); }
            }
        }
    }
};

constexpr int LDS_HALO = LDSCTL_OFF + 1024, LDS_CWL = LDS_HALO + 4 * 2 * 256 * 4;
static_assert(LDS_CWL + 4 * 256 * 4 <= LDS_BYTES, "epilogue LDS");
__device__ __forceinline__ float dpp_ror1(float x) { return __builtin_bit_cast(float, __builtin_amdgcn_mov_dpp(__builtin_bit_cast(int, x), 0x121, 0xf, 0xf, false)); }
__device__ __forceinline__ float dpp_ror2(float x) { return __builtin_bit_cast(float, __builtin_amdgcn_mov_dpp(__builtin_bit_cast(int, x), 0x122, 0xf, 0xf, false)); }
struct EpiUpConv {
    static constexpr bool PERM = true, AFTER_DRAIN = false;
    const float* ssq; bf16* ACT; float* UB; float* US; float* convP; const float* cw; const float* cb; LAS unsigned char* lds;
    __device__ __forceinline__ void operator()(const f32x4 (&acc_in)[2][2][4][2], const Unit& u, int wr, int wc, int fr_in, int fq_in) const {
        LAS float* HALO = (LAS float*)(lds + LDS_HALO); LAS float* CWL = (LAS float*)(lds + LDS_CWL);
        int lane_ = fr_in + 16 * fq_in; asm volatile("" : "+v"(lane_));
        const int fr = lane_ & 15, fq = lane_ >> 4;
        const int tid = (wr * 4 + wc) * 64 + lane_, pn = u.pn; const bool samp_panel = u.pm >= MP / 256;
        f32x4 (&acc)[2][2][4][2] = const_cast<f32x4 (&)[2][2][4][2]>(acc_in);
        float cpv[2], sq8[2][4];
#pragma unroll
        for (int i = 0; i < 2; ++i) { const int id = tid * 2 + i, tc = id >> 2, k = id & 3, chn = ((tc >> 7) ? DFF : 0) + 128 * pn + (tc & 127); const float* p_ = k < 3 ? cw + (size_t)k * NUP + chn : cb + chn; cpv[i] = *p_; }
#pragma unroll
        for (int ai = 0; ai < 2; ++ai)
#pragma unroll
            for (int m = 0; m < 4; ++m) sq8[ai][m] = *(const float*)((const char*)ssq + (unsigned)EPI_ROW(u, ai, wr, m, fr) * 4u);
        __builtin_amdgcn_sched_barrier(0);
#pragma unroll
        for (int ai = 0; ai < 2; ++ai)
#pragma unroll
            for (int m = 0; m < 4; ++m) { const float rs = rsqrtf(sq8[ai][m] * (1.0f / DM) + EPS);
#pragma unroll
                for (int bj = 0; bj < 2; ++bj) { acc[ai][bj][m][0] *= rs; acc[ai][bj][m][1] *= rs; } }
#pragma unroll
        for (int i = 0; i < 2; ++i) CWL[tid * 2 + i] = cpv[i];
        if (fr >= 14) {
#pragma unroll
            for (int ai = 0; ai < 2; ++ai)
#pragma unroll
                for (int bj = 0; bj < 2; ++bj) { LAS float* hp = HALO + ((ai * 2 + wr) * 2 + (fr - 14)) * 256 + 128 * bj + 32 * wc + 8 * fq;
                    *(LAS f32x4*)hp = acc[ai][bj][3][0]; *(LAS f32x4*)(hp + 4) = acc[ai][bj][3][1]; }
        }
        asm volatile("s_waitcnt lgkmcnt(0)" ::: "memory"); __builtin_amdgcn_s_barrier(); asm volatile("" ::: "memory");
        const int tca = 32 * wc + 8 * fq;
        if (samp_panel) {
#pragma unroll
            for (int ai = 0; ai < 2; ++ai)
#pragma unroll
                for (int m = 0; m < 4; ++m) { float* us = US + (size_t)(EPI_ROW(u, ai, wr, m, fr) - MP) * NUP + 128 * pn + tca;
#pragma unroll
                    for (int bj = 0; bj < 2; ++bj) { *(f32x4*)(us + bj * DFF) = acc[ai][bj][m][0]; *(f32x4*)(us + bj * DFF + 4) = acc[ai][bj][m][1]; } }
            return;
        }
        const bool seq_start = (u.pm & 15) == 0;
        float pu[2][8];
#pragma unroll
        for (int ai = 0; ai < 2; ++ai)
#pragma unroll
            for (int m = 0; m < 4; ++m) {
                const int row = EPI_ROW(u, ai, wr, m, fr);
                if (m == 0) { const int blk = ai * 2 + wr;
#pragma unroll
                    for (int bj = 0; bj < 2; ++bj)
#pragma unroll
                        for (int e8 = 0; e8 < 8; ++e8) pu[bj][e8] = (blk > 0 && fr >= 14) ? HALO[((blk - 1) * 2 + (fr - 14)) * 256 + 128 * bj + tca + e8] : 0.f; }
                float res[8];
#pragma unroll
                for (int e8 = 0; e8 < 8; ++e8) {
                    const f32x4 wa = *(const LAS f32x4*)(CWL + (tca + e8) * 4), wv = *(const LAS f32x4*)(CWL + (128 + tca + e8) * 4);
                    const float ua = acc[ai][0][m][e8 >> 2][e8 & 3], uv = acc[ai][1][m][e8 >> 2][e8 & 3];
                    const float t1a = fr == 15 ? pu[0][e8] : ua, t2a = fr >= 14 ? pu[0][e8] : ua, t1v = fr == 15 ? pu[1][e8] : uv, t2v = fr >= 14 ? pu[1][e8] : uv;
                    const float x1a = dpp_ror1(t1a), x2a = dpp_ror2(t2a), x1v = dpp_ror1(t1v), x2v = dpp_ror2(t2v);
                    const float ya = wa[3] + wa[0] * x2a + wa[1] * x1a + wa[2] * ua, yv = wv[3] + wv[0] * x2v + wv[1] * x1v + wv[2] * uv;
                    res[e8] = ya * __builtin_amdgcn_rcpf(1.0f + __expf(-ya)) * yv;
                    if (e8 & 1) asm volatile("" ::: "memory");
                }
#pragma unroll
                for (int bj = 0; bj < 2; ++bj)
#pragma unroll
                    for (int e8 = 0; e8 < 8; ++e8) pu[bj][e8] = acc[ai][bj][m][e8 >> 2][e8 & 3];
                const bool skip = !seq_start && ai == 0 && wr == 0 && m == 0 && fr < 2;
                v4u w; w.x = cvt_pk_bf16(res[0], res[1]); w.y = cvt_pk_bf16(res[2], res[3]); w.z = cvt_pk_bf16(res[4], res[5]); w.w = cvt_pk_bf16(res[6], res[7]);
                if (!skip) *(v4u*)((char*)ACT + (unsigned)(row * DFF + 128 * pn + tca) * 2u) = w;
                asm volatile("" ::: "memory");
            }
#pragma unroll
        for (int ai = 0; ai < 2; ++ai)
#pragma unroll
            for (int m = 0; m < 4; m += 3) { if ((ai == 0 && m == 0) || (ai == 1 && m == 3)) {
                const int row = EPI_ROW(u, ai, wr, m, fr); const int rt = row & 255, t = row & 4095;
                float* st = (t >= SEQ - 2) ? convP + ((size_t)(row >> 12) * 2 + (t - (SEQ - 2))) * NUP : nullptr;
                float* ub = (rt < 2 || rt >= 254) ? UB + ((size_t)u.pm * 4 + (rt < 2 ? rt : rt - 252)) * NUP : nullptr;
#pragma unroll
                for (int bj = 0; bj < 2; ++bj) { const int c0 = bj * DFF + 128 * pn + tca; const f32x4 y0 = acc[ai][bj][m][0], y1 = acc[ai][bj][m][1];
                    if (st) { *(f32x4*)(st + c0) = y0; *(f32x4*)(st + c0 + 4) = y1; }
                    if (ub) { *(f32x4*)(ub + c0) = y0; *(f32x4*)(ub + c0 + 4) = y1; } } } }
    }
};

struct EpiInPool {
    static constexpr bool PERM = true, AFTER_DRAIN = false;
    const float* ssq; const float* xqgain; float* UP; float* XQf; float* out; bf16* XQb;
    __device__ __forceinline__ void operator()(const f32x4 (&acc)[2][2][4][2], const Unit& u, int wr, int wc, int fr_in, int fq_in) const {
        int lane_ = fr_in + 16 * fq_in; asm volatile("" : "+v"(lane_)); const int fr = lane_ & 15, fq = lane_ >> 4;
        const int pn = u.pn;
        float sq8[2][4];
#pragma unroll
        for (int ai = 0; ai < 2; ++ai)
#pragma unroll
            for (int m = 0; m < 4; ++m) sq8[ai][m] = ssq[EPI_ROW(u, ai, wr, m, fr)];
        __builtin_amdgcn_sched_barrier(0);
#pragma unroll
        for (int ai = 0; ai < 2; ++ai)
#pragma unroll
            for (int m = 0; m < 4; ++m) {
                const int row = EPI_ROW(u, ai, wr, m, fr);
                const float rstd = rsqrtf(sq8[ai][m] * (1.0f / DM) + EPS);
                float v[16]; float ss = 0.f;
#pragma unroll
                for (int bj = 0; bj < 2; ++bj)
#pragma unroll
                    for (int n = 0; n < 2; ++n)
#pragma unroll
                        for (int e = 0; e < 4; ++e) { const float x = acc[ai][bj][m][n][e] * rstd; v[bj * 8 + n * 4 + e] = x; ss += x * x; }
                if (pn < 3) {
                    float* st = nullptr;
                    if (row >= MP) { const int rs = row - MP; st = out + O_POOLS + ((size_t)(rs >> 3) * 15 + 7 + (rs & 7)) * 768; }
                    else { const int t = row & 4095; if (t >= SEQ - 15) st = out + O_POOLP + ((size_t)(row >> 12) * 15 + (t - (SEQ - 15))) * 768; }
#pragma unroll
                    for (int bj = 0; bj < 2; ++bj) { const int c0 = pn * 256 + wc * 64 + 32 * bj + 8 * fq;
                        const f32x4 a = (f32x4){v[bj * 8 + 0], v[bj * 8 + 1], v[bj * 8 + 2], v[bj * 8 + 3]}, b = (f32x4){v[bj * 8 + 4], v[bj * 8 + 5], v[bj * 8 + 6], v[bj * 8 + 7]};
                        *(f32x4*)(UP + (size_t)row * 768 + c0) = a; *(f32x4*)(UP + (size_t)row * 768 + c0 + 4) = b;
                        if (st) { *(f32x4*)(st + c0) = a; *(f32x4*)(st + c0 + 4) = b; } }
                } else {
                    ss = fq_sum(ss);
                    const float hn = rsqrtf(ss * (1.0f / 64.0f) + EPS);
#pragma unroll
                    for (int bj = 0; bj < 2; ++bj) { const int d0 = 32 * bj + 8 * fq;
                        const f32x4 g0 = *(const f32x4*)(xqgain + d0), g1 = *(const f32x4*)(xqgain + d0 + 4);
                        const f32x4 a = (f32x4){v[bj * 8 + 0] * hn * g0[0], v[bj * 8 + 1] * hn * g0[1], v[bj * 8 + 2] * hn * g0[2], v[bj * 8 + 3] * hn * g0[3]};
                        const f32x4 b = (f32x4){v[bj * 8 + 4] * hn * g1[0], v[bj * 8 + 5] * hn * g1[1], v[bj * 8 + 6] * hn * g1[2], v[bj * 8 + 7] * hn * g1[3]};
                        if (row >= MP) { float* dst = XQf + (size_t)row * 256 + wc * 64 + d0; *(f32x4*)dst = a; *(f32x4*)(dst + 4) = b; }
                        else { v4u w; w.x = cvt_pk_bf16(a[0] * QSCALE_, a[1] * QSCALE_); w.y = cvt_pk_bf16(a[2] * QSCALE_, a[3] * QSCALE_); w.z = cvt_pk_bf16(b[0] * QSCALE_, b[1] * QSCALE_); w.w = cvt_pk_bf16(b[2] * QSCALE_, b[3] * QSCALE_);
                            *(v4u*)(XQb + (size_t)row * 256 + wc * 64 + d0) = w; } }
                }
            }
    }
};

struct Args { const void* in[N_IN]; float* out; unsigned char* ws; int ph_lo, ph_hi; };
struct Frame {
    LAS unsigned char* lds; int tid, lane, wave, G, gw, NGW;
    const void* const* in; float* out; unsigned char* ws;
};
#define FIN(F, i) ((const float*)(F).in[i])

__device__ __forceinline__ void tr_item(const float* W, int ldw, const float* gain, bf16* Bt, int Kdim, int k0, int n0, int srccol0, int ncols_valid, LAS float* scr, int lane) {
    const int j = lane & 31, kh = lane >> 5; const bool ok = j < ncols_valid;
    const float* wp = W + (size_t)(k0 + kh) * ldw + (ok ? srccol0 + j : 0);
    float v[32];
#pragma unroll
    for (int i = 0; i < 32; ++i) v[i] = wp[(size_t)(2 * i) * ldw];
    __builtin_amdgcn_sched_barrier(0);
#pragma unroll
    for (int i = 0; i < 32; ++i) scr[(2 * i + kh) * 33 + j] = ok ? v[i] : 0.f;
    LDS_WAIT(); asm volatile("" ::: "memory");
    const int c = lane & 7;
    f32x4 g0 = (f32x4){1.f, 1.f, 1.f, 1.f}, g1 = g0;
    if (gain) { g0 = *(const f32x4*)(gain + k0 + 8 * c); g1 = *(const f32x4*)(gain + k0 + 8 * c + 4); }
#pragma unroll
    for (int jj = 0; jj < 4; ++jj) { const int n = (lane >> 3) + 8 * jj; const LAS float* s = scr + (8 * c) * 33 + n;
        v4u o; o.x = cvt_pk_bf16(s[0 * 33] * g0[0], s[1 * 33] * g0[1]); o.y = cvt_pk_bf16(s[2 * 33] * g0[2], s[3 * 33] * g0[3]); o.z = cvt_pk_bf16(s[4 * 33] * g1[0], s[5 * 33] * g1[1]); o.w = cvt_pk_bf16(s[6 * 33] * g1[2], s[7 * 33] * g1[3]);
        *(v4u*)(Bt + (size_t)(n0 + n) * Kdim + k0 + 8 * c) = o; }
    LDS_WAIT(); asm volatile("" ::: "memory");
}
__device__ __forceinline__ int hpw_src(int n) { return (n & ~255) + ((n >> 5) & 3) * 64 + ((n >> 7) & 1) * 32 + (n & 31); }

__device__ __forceinline__ void tr_matrix(Frame& F, int& cursor, const float* W, int ldw, int ncols, const float* gain, bf16* Bt, int N, int K, int mode, LAS float* scr) {
    const int nkb = K / 64, nnb = N / 32, items = nkb * nnb;
    int first = (F.gw - (cursor % F.NGW) + F.NGW) % F.NGW;
    for (int it = first; it < items; it += F.NGW) {
        const int kb = it / nnb, nb = it % nnb, n0 = nb * 32; int src = (mode == 1 || mode == 2) ? hpw_src(n0) : n0;
        int nv = ncols - src; nv = nv < 0 ? 0 : (nv > 32 ? 32 : nv);
        if (mode == 3) { src = ((n0 >> 7) & 1) * DFF + 128 * (n0 >> 8) + (n0 & 127); nv = 32; }
        if (mode == 2) {
            if (src >= 1792) { const int off = src - 1792; nv = 36 - off; nv = nv < 0 ? 0 : (nv > 32 ? 32 : nv); src = 1536 + off; }
            else if (src >= 1536) { src += 36; nv = 32; }
            else nv = 32; }
        tr_item(W, ldw, gain, Bt, K, kb * 64, n0, src, nv, scr, F.lane);
    }
    cursor += items;
}

__device__ __forceinline__ void p0_prologue(Frame& F, bool first) {
    LAS float* scr = (LAS float*)(F.lds + RING_OFF + F.wave * 16384);
    unsigned char* ws = F.ws;
    int cur = 0;
    tr_matrix(F, cur, FIN(F, I_WINNSA), NSA_IN, NSA_IN, FIN(F, I_GMIX), (bf16*)(ws + WS_WIN0), NIN0, DM, 2, scr);
    tr_matrix(F, cur, FIN(F, I_WINPOOL), DM, DM, FIN(F, I_GMIX) + DM, (bf16*)(ws + WS_WIN1), DM, DM, 1, scr);
    tr_matrix(F, cur, FIN(F, I_WMEMKV), 512, 512, FIN(F, I_GMEM), (bf16*)(ws + WS_WMEM), 512, DM, 1, scr);
    tr_matrix(F, cur, FIN(F, I_WMEMKV) + (size_t)DM * 512, 512, 512, FIN(F, I_GMEM) + DM, (bf16*)(ws + WS_WMEM) + (size_t)512 * DM, 512, DM, 1, scr);
    tr_matrix(F, cur, FIN(F, I_WOUT), DM, DM, nullptr, (bf16*)(ws + WS_WOUT), DM, DM, 0, scr);
    {
        const float* W = FIN(F, I_WOUT) + (size_t)DM * DM + (size_t)768 * DM; bf16* Bt = (bf16*)(ws + WS_WOUT) + (size_t)DM * DM + 768;
        const int nkb = 4, nnb = DM / 32, items = nkb * nnb; int first = (F.gw - (cur % F.NGW) + F.NGW) % F.NGW;
        for (int it = first; it < items; it += F.NGW) { const int kb = it / nnb, nb = it % nnb; tr_item(W, DM, nullptr, Bt, DM, kb * 64, nb * 32, nb * 32, 32, scr, F.lane); }
        cur += items;
    }
    for (int l = 0; l < 2; ++l) tr_matrix(F, cur, FIN(F, I_WUP) + (size_t)l * DM * NUP, NUP, NUP, FIN(F, I_GFFN) + l * DM, (bf16*)(ws + WS_WUP) + (size_t)l * NUP * DM, NUP, DM, 3, scr);
    for (int l = 0; l < 2; ++l) tr_matrix(F, cur, FIN(F, I_WDOWN) + (size_t)l * DFF * DM, DM, DM, nullptr, (bf16*)(ws + WS_WDOWN) + (size_t)l * DM * DFF, DM, DFF, 0, scr);
    for (int w = 0; w < 2; ++w) tr_matrix(F, cur, FIN(F, I_CW1) + (size_t)w * 4096 * 128, 128, 128, nullptr, (bf16*)(ws + WS_WC1B) + (size_t)w * 256 * 4096, 128, 4096, 0, scr);
    {
        const float* Wg = FIN(F, I_WPG); const float* sc = FIN(F, I_PSCALE); const float* wo = FIN(F, I_WOUT) + (size_t)DM * DM; bf16* Bt = (bf16*)(ws + WS_WOUT) + (size_t)DM * DM;
        for (int task = F.gw; task < 96 * 16; task += F.NGW) { const int kc0 = (task >> 4) * 8, n = (task & 15) * 64 + F.lane, g = kc0 / 192;
            const float* wr = Wg + (size_t)kc0 * 192;
            const float* wop = wo + (size_t)(g * 192) * DM + n; const float* scp = sc + g * 192;
            float a[8];
#pragma unroll
            for (int r = 0; r < 8; ++r) a[r] = 0.f;
            { f32x4 t[6];
#pragma unroll
              for (int q = 0; q < 6; ++q) t[q] = *(const f32x4*)(wr + (q * 64 + F.lane) * 4);
#pragma unroll
              for (int q = 0; q < 6; ++q) { const int e = (q * 64 + F.lane) * 4, d = e % 192; const f32x4 s4 = *(const f32x4*)(scp + d); *(LAS f32x4*)(scr + e) = t[q] * s4; }
              LDS_WAIT(); asm volatile("" ::: "memory"); }
#pragma unroll 1
            for (int d0 = 0; d0 < 192; d0 += 16) { float x[16];
#pragma unroll
                for (int dd = 0; dd < 16; ++dd) x[dd] = wop[(size_t)(d0 + dd) * DM];
                __builtin_amdgcn_sched_barrier(0);
#pragma unroll
                for (int d4 = 0; d4 < 4; ++d4) {
#pragma unroll
                    for (int r = 0; r < 8; ++r) { const f32x4 w4 = *(const LAS f32x4*)(scr + r * 192 + d0 + 4 * d4); a[r] += (w4[0] * x[4 * d4] + w4[1] * x[4 * d4 + 1]) + (w4[2] * x[4 * d4 + 2] + w4[3] * x[4 * d4 + 3]); }
                    __builtin_amdgcn_sched_barrier(0); }
            }
            LDS_WAIT(); asm volatile("" ::: "memory");
            v4u o; o.x = cvt_pk_bf16(a[0], a[1]); o.y = cvt_pk_bf16(a[2], a[3]); o.z = cvt_pk_bf16(a[4], a[5]); o.w = cvt_pk_bf16(a[6], a[7]);
            *(v4u*)(Bt + (size_t)n * DM + kc0) = o; }
    }
    {
        bf16* XB = (bf16*)(ws + WS_XB); float* ssq0 = (float*)(ws + WS_SSQ0);
        f32x4 v[8];
#define P0_LDX(dst, m2_) do { const int m_ = (m2_) * 2; const float* xr_ = m_ < MP ? FIN(F, I_XP) + (size_t)m_ * DM : FIN(F, I_XS) + (size_t)(m_ - MP) * DM; const f32x4* x4_ = (const f32x4*)xr_ + F.lane; _Pragma("unroll") for (int j = 0; j < 8; ++j) dst[j] = x4_[64 * j]; } while (0)
        if (F.gw < MT / 2) P0_LDX(v, F.gw);
#pragma unroll 1
        for (int m2 = F.gw; m2 < MT / 2; m2 += F.NGW) { const int m = m2 * 2;
            f32x4 vn[8]; const bool more = m2 + F.NGW < MT / 2;
            if (more) P0_LDX(vn, m2 + F.NGW);
            __builtin_amdgcn_sched_barrier(0);
            float s0 = 0.f, s1 = 0.f;
#pragma unroll
            for (int j = 0; j < 4; ++j) { s0 += (v[j][0] * v[j][0] + v[j][1] * v[j][1]) + (v[j][2] * v[j][2] + v[j][3] * v[j][3]); s1 += (v[4 + j][0] * v[4 + j][0] + v[4 + j][1] * v[4 + j][1]) + (v[4 + j][2] * v[4 + j][2] + v[4 + j][3] * v[4 + j][3]); }
            s0 = wave_sum(s0); s1 = wave_sum(s1); if (F.lane == 0) { ssq0[m] = s0; ssq0[m + 1] = s1; }
            v2u* o = (v2u*)(XB + (size_t)m * DM) + F.lane;
#pragma unroll
            for (int j = 0; j < 8; ++j) { v2u w; w.x = cvt_pk_bf16(v[j][0], v[j][1]); w.y = cvt_pk_bf16(v[j][2], v[j][3]); o[64 * j] = w; }
            if (more) {
#pragma unroll
                for (int j = 0; j < 8; ++j) v[j] = vn[j]; }
        }
#undef P0_LDX
    }
    {
        bf16* MN = (bf16*)(ws + WS_MEMN);
        for (int m = F.gw; m < NB * NMEM; m += F.NGW) {
            const f32x4* x4 = (const f32x4*)(FIN(F, I_MEMP) + (size_t)m * DM) + F.lane; f32x4 v[4]; float s = 0.f;
#pragma unroll
            for (int j = 0; j < 4; ++j) { v[j] = x4[64 * j]; s += (v[j][0] * v[j][0] + v[j][1] * v[j][1]) + (v[j][2] * v[j][2] + v[j][3] * v[j][3]); }
            s = wave_sum(s); const float r = rsqrtf(s * (1.0f / DM) + EPS);
            v2u* o = (v2u*)(MN + (size_t)m * DM) + F.lane;
#pragma unroll
            for (int j = 0; j < 4; ++j) { v2u w; w.x = cvt_pk_bf16(v[j][0] * r, v[j][1] * r); w.y = cvt_pk_bf16(v[j][2] * r, v[j][3] * r); o[64 * j] = w; }
        }
    }
    {
        const int gt = F.gw * 64 + F.lane, GT = F.NGW * 64;
        const f32x4* cw = (const f32x4*)FIN(F, I_CWIN); f32x4* ow = (f32x4*)(F.out + O_WINS);
#pragma unroll 1
        for (int idx0 = gt; idx0 < DBATCH * 504 * 64; idx0 += 8 * GT) { f32x4 t[8];
#pragma unroll
            for (int q = 0; q < 8; ++q) { int idx = idx0 + q * GT; idx = idx < DBATCH * 504 * 64 ? idx : gt; const int b = idx / (504 * 64), r = idx % (504 * 64); t[q] = __builtin_nontemporal_load(cw + (size_t)b * 512 * 64 + 8 * 64 + r); }
#pragma unroll
            for (int q = 0; q < 8; ++q) { const int idx = idx0 + q * GT; if (idx < DBATCH * 504 * 64) { const int b = idx / (504 * 64), r = idx % (504 * 64); ow[(size_t)b * 512 * 64 + r] = t[q]; } } }
        const f32x4* sp = (const f32x4*)FIN(F, I_SPOOL); f32x4* op = (f32x4*)(F.out + O_POOLS);
        for (int idx = gt; idx < DBATCH * 7 * 192; idx += GT) { const int b = idx / (7 * 192), r = idx % (7 * 192); op[(size_t)b * 15 * 192 + r] = sp[(size_t)b * 15 * 192 + 8 * 192 + r]; }
    }
    {
        float* b1eff = (float*)(ws + WS_CTL) + CW_B1EFF;
        for (int task = (F.gw + F.NGW - 1600 % F.NGW) % F.NGW; task < (first ? 2 * 64 : 0); task += F.NGW) { const int w = task >> 6, kc = task & 63;
            const float* pos = FIN(F, I_CPOS) + (size_t)w * 4096 + kc * 64; const float* w1 = FIN(F, I_CW1) + ((size_t)w * 4096 + kc * 64) * 128;
            float a0 = 0.f, a1 = 0.f;
#pragma unroll 16
            for (int k = 0; k < 64; ++k) { const float p = pos[k]; a0 += p * w1[k * 128 + F.lane]; a1 += p * w1[k * 128 + 64 + F.lane]; }
            atomicAdd(b1eff + w * 128 + F.lane, a0); atomicAdd(b1eff + w * 128 + 64 + F.lane, a1); }
    }
}

__device__ __forceinline__ void p3_compress2(Frame& F) {
    const float* H1 = (const float*)(F.ws + WS_H1); float* KC = (float*)(F.ws + WS_KC);
    static_assert(CMP_ROWS % 4 == 0 && CMP_ROWS_P % 4 == 0, "four rows per task");
#pragma unroll 1
    for (int task = F.gw; task < 2 * CMP_ROWS / 4; task += F.NGW) { const int w = task / (CMP_ROWS / 4), row0 = (task % (CMP_ROWS / 4)) * 4;
        const float* h = H1 + ((size_t)w * CMP_ROWS + row0) * 128; const float* w2 = FIN(F, I_CW2) + (size_t)w * 128 * 64 + F.lane;
        const float bias = FIN(F, I_CB2)[w * 64 + F.lane];
        int hv[4][2];
#pragma unroll
        for (int r = 0; r < 4; ++r) { hv[r][0] = __builtin_bit_cast(int, h[r * 128 + F.lane]); hv[r][1] = __builtin_bit_cast(int, h[r * 128 + 64 + F.lane]); }
        float a[4] = {bias, bias, bias, bias};
#pragma unroll
        for (int half = 0; half < 2; ++half) {
#pragma unroll 8
            for (int k = 0; k < 64; ++k) { const float wv = w2[(half * 64 + k) * 64];
#pragma unroll
                for (int r = 0; r < 4; ++r) a[r] += __builtin_bit_cast(float, __builtin_amdgcn_readlane(hv[r][half], k)) * wv; }
        }
#pragma unroll
        for (int r = 0; r < 4; ++r) { const int row = row0 + r; float av = a[r];
            if (w == 0) { const float ss = wave_sum(av * av); av = av * rsqrtf(ss * (1.0f / 64.0f) + EPS) * FIN(F, I_KG)[F.lane]; }
            KC[((size_t)w * CMP_ROWS + row) * 64 + F.lane] = av;
            if (row < CMP_ROWS_P) { const int bc = row >> 1, g = row & 1, b_ = bc >> 6, c = bc & 63, bg = b_ * 2 + g; const bf16 hb = (bf16)(cvt_pk_bf16(av, 0.f) & 0xffffu);
                if (w == 0) ((bf16*)(F.ws + WS_KCB))[((size_t)bg * 64 + c) * 64 + F.lane] = hb; else ((bf16*)(F.ws + WS_VCT))[((size_t)bg * 64 + F.lane) * 64 + c] = hb; } }
    }
}


namespace at {
typedef short bf16x8 __attribute__((ext_vector_type(8)));
constexpr int TILE_B = 8192;
constexpr int L_KBUF = 0, L_VBUF = 4 * TILE_B, L_IMP = 8 * TILE_B, L_SEL = L_IMP + 2 * 64 * 64 * 4, L_END = L_SEL + 512;
constexpr int BT_PITCH = 132;
constexpr float LOG2E = 1.4426950408889634f, QSCALE = 0.125f * LOG2E, NEG = -1e30f;
static_assert(L_END <= 100352, "attention LDS map (tables start at 100352)");

struct TileSrc { const bf16* k; const bf16* v; int vpitch; };
__device__ __forceinline__ v4u ldg16(const void* ubase, unsigned off) { return *(const v4u*)((const char*)ubase + off); }
__device__ __forceinline__ void tile_load(const TileSrc& t, int tid, v4u& kr, v4u& vr) {
    const int r = (tid >> 6) * 8 + (tid & 7), c = (tid >> 3) & 7;
    kr = ldg16(t.k, (unsigned)(r * 128 + c * 16));
    vr = ldg16(t.v, (unsigned)(r * t.vpitch * 2 + c * 16));
}
__device__ __forceinline__ void tile_store(LAS unsigned char* lds, int buf, int tid, const v4u& kr, const v4u& vr) {
    const int r = (tid >> 6) * 8 + (tid & 7), c = (tid >> 3) & 7, ds = c >> 2, fq = c & 3;
    const int kb = 2 * (r >> 5) + ((r >> 2) & 1), rho = 4 * ((r >> 3) & 3) + (r & 3);
    *(LAS v4u*)(lds + L_KBUF + buf * TILE_B + ((kb * 2 + ds) * 64 + rho + 16 * fq) * 16) = kr;
    *(LAS v4u*)(lds + L_VBUF + buf * TILE_B + (((r >> 4) * 2 + ds) * 64 + (r & 15) + 16 * fq) * 16) = vr;
}
__device__ __forceinline__ f32x4 splat4(float x) { return (f32x4){x, x, x, x}; }

template <int R, int KIND>
__device__ __forceinline__ void att_step(const LAS unsigned char* kb_, const LAS unsigned char* vb_, const bf16x8 (&qf)[R][2], const float (&cinit)[R], bool lane_on, int klo, int khi, int dbase, int qi,
                                         const LAS float* btab, const int (&hidx)[R], f32x4 (&o)[R][4], float (&lsum)[R], f32x4 (&impacc)[4], int lane) {
    const int fq = lane >> 4;
    const LAS unsigned char* kp = kb_ + lane * 16;
    const LAS unsigned char* vp = vb_ + lane * 16;
    bf16x8 kf[4][2];
#pragma unroll
    for (int kb = 0; kb < 4; ++kb)
#pragma unroll
        for (int ds = 0; ds < 2; ++ds) kf[kb][ds] = *(const LAS bf16x8*)(kp + (kb * 2 + ds) * 1024);
    bf16x8 pf[R][2];
#pragma unroll
    for (int r = 0; r < R; ++r) {
        f32x4 s[4]; const f32x4 c0 = splat4(lane_on ? cinit[r] : NEG);
#pragma unroll
        for (int kb = 0; kb < 4; ++kb) { s[kb] = __builtin_amdgcn_mfma_f32_16x16x32_bf16(kf[kb][0], qf[r][0], c0, 0, 0, 0); s[kb] = __builtin_amdgcn_mfma_f32_16x16x32_bf16(kf[kb][1], qf[r][1], s[kb], 0, 0, 0); }
        if (KIND != 0) {
            const LAS float* bt = btab + hidx[r] * BT_PITCH;
            const int d0 = dbase + qi - 8 * fq * (KIND == 2 ? 64 : 1);
#pragma unroll
            for (int kb = 0; kb < 4; ++kb)
#pragma unroll
                for (int e = 0; e < 4; ++e) { const int ko = 32 * (kb >> 1) + 4 * (kb & 1) + e;
                    const int dist = d0 - ko * (KIND == 2 ? 64 : 1); const int dc = dist < 0 ? 0 : (dist > 128 ? 128 : dist);
                    float bv_ = bt[dc]; asm volatile("" : "+v"(bv_));
                    float x = s[kb][e] + bv_;
                    if (KIND == 2) x = dist < 0 ? NEG : x;
                    else { const int key = 8 * fq + ko; x = (key < klo || key > khi) ? NEG : x; }
                    s[kb][e] = x; }
        }
        float rs = 0.f;
#pragma unroll
        for (int kb = 0; kb < 4; ++kb)
#pragma unroll
            for (int e = 0; e < 4; ++e) { const float p = __builtin_amdgcn_exp2f(s[kb][e]); s[kb][e] = p; rs += p; }
        lsum[r] += rs;
        if (KIND == 2) { const float lt = fq_sum(rs); const float inv = lt > 0.f ? 1.0f / lt : 0.f;
#pragma unroll
            for (int kb = 0; kb < 4; ++kb) impacc[kb] += s[kb] * inv; }
#pragma unroll
        for (int ks = 0; ks < 2; ++ks) { v4u w; w.x = cvt_pk_bf16(s[2 * ks][0], s[2 * ks][1]); w.y = cvt_pk_bf16(s[2 * ks][2], s[2 * ks][3]); w.z = cvt_pk_bf16(s[2 * ks + 1][0], s[2 * ks + 1][1]); w.w = cvt_pk_bf16(s[2 * ks + 1][2], s[2 * ks + 1][3]);
            pf[r][ks] = __builtin_bit_cast(bf16x8, w); }
    }
    bf16x8 vf[4][2];
#pragma unroll
    for (int db = 0; db < 4; ++db)
#pragma unroll
        for (int ks = 0; ks < 2; ++ks) vf[db][ks] = *(const LAS bf16x8*)(vp + (db * 2 + ks) * 1024);
    __builtin_amdgcn_s_setprio(1);
#pragma unroll
    for (int r = 0; r < R; ++r)
#pragma unroll
        for (int db = 0; db < 4; ++db) { o[r][db] = __builtin_amdgcn_mfma_f32_16x16x32_bf16(vf[db][0], pf[r][0], o[r][db], 0, 0, 0); o[r][db] = __builtin_amdgcn_mfma_f32_16x16x32_bf16(vf[db][1], pf[r][1], o[r][db], 0, 0, 0); }
    __builtin_amdgcn_s_setprio(0);
}

__device__ __forceinline__ void nsa_unit(Frame& F, int b, int g, int i, const LAS float* btab, float B2) {
    int tid = F.tid; asm volatile("" : "+v"(tid));
    const int lane = tid & 63, w = F.wave, rho = lane & 15, fq = lane >> 4;
    const int qq = w & 3, hb = g * 6 + 3 * (w >> 2), qi = 16 * qq + rho, row = b * SEQ + 64 * i + qi;
    LAS unsigned char* lds = F.lds; unsigned char* ws = F.ws;
    const unsigned qoff = (unsigned)(row * 768 + hb * 64 + fq * 8) * 2u;
    bf16x8 qf[3][2];
#pragma unroll
    for (int r = 0; r < 3; ++r)
#pragma unroll
        for (int ds = 0; ds < 2; ++ds) qf[r][ds] = __builtin_bit_cast(bf16x8, ldg16(ws + WS_QB, qoff + (unsigned)(r * 64 + ds * 32) * 2u));
    const int hidx[3] = {hb, hb + 1, hb + 2};
    const float cnear[3] = {-B2, -B2, -B2};
    v2u out[3][4]; f32x4 o[3][4], impacc[4]; float lsum[3];
#pragma unroll
    for (int r = 0; r < 3; ++r) { lsum[r] = 0.f;
#pragma unroll
        for (int db = 0; db < 4; ++db) { out[r][db] = (v2u){0u, 0u}; o[r][db] = splat4(0.f); } }
#pragma unroll
    for (int kb = 0; kb < 4; ++kb) impacc[kb] = splat4(0.f);
#define AT_FINALIZE(br) do { _Pragma("unroll") for (int r = 0; r < 3; ++r) { const float l = fq_sum(lsum[r]); const float gt_ = *(const float*)((const char*)(ws + WS_G) + (unsigned)(row * 64 + hb * 3 + r * 3 + br) * 4u); const float inv = l > 0.f ? gt_ / l : 0.f; \
        _Pragma("unroll") for (int db = 0; db < 4; ++db) { const v2u pv_ = out[r][db]; const f32x4 t_ = o[r][db] * inv; \
            out[r][db].x = cvt_pk_bf16(__uint_as_float(pv_.x << 16) + t_[0], __uint_as_float(pv_.x & 0xffff0000u) + t_[1]); out[r][db].y = cvt_pk_bf16(__uint_as_float(pv_.y << 16) + t_[2], __uint_as_float(pv_.y & 0xffff0000u) + t_[3]); \
            o[r][db] = splat4(0.f); } lsum[r] = 0.f; } } while (0)
    const int bg = b * 2 + g;
    v4u kr, vr;
    if (tid < 128) ((LAS unsigned*)(lds + L_SEL))[tid] = 0u;
    { TileSrc tc{(const bf16*)(ws + WS_KCB) + (size_t)bg * 64 * 64, (const bf16*)(ws + WS_VCT) + (size_t)bg * 64 * 64, 64};
      tile_load(tc, tid, kr, vr); tile_store(lds, 3, tid, kr, vr); LDS_WAIT(); __syncthreads();
      att_step<3, 2>(lds + L_KBUF + 3 * TILE_B, lds + L_VBUF + 3 * TILE_B, qf, cnear, true, 0, 63, 64 * i - 63, qi, btab, hidx, o, lsum, impacc, lane);
      AT_FINALIZE(0); }
    unsigned long long sel;
    if (i >= 16) {
        LAS float* IMP = (LAS float*)(lds + L_IMP);
#pragma unroll
        for (int kb = 0; kb < 4; ++kb)
#pragma unroll
            for (int e = 0; e < 4; ++e) { const int c = 32 * (kb >> 1) + 8 * fq + 4 * (kb & 1) + e; IMP[((w >> 2) * 64 + c) * 64 + qi] = impacc[kb][e]; }
        LDS_WAIT(); __syncthreads();
        const int q = tid & 63, cg = tid >> 6; float val[8];
#pragma unroll
        for (int k = 0; k < 8; ++k) { const int c = cg * 8 + k; val[k] = IMP[c * 64 + q] + IMP[(64 + c) * 64 + q]; }
        LDS_WAIT(); __syncthreads();
#pragma unroll
        for (int k = 0; k < 8; ++k) IMP[(cg * 8 + k) * 64 + q] = val[k];
        LDS_WAIT(); __syncthreads();
        int cnt[8];
#pragma unroll
        for (int k = 0; k < 8; ++k) cnt[k] = 0;
#pragma unroll 4
        for (int c2 = 1; c2 <= i - 2; ++c2) { const float v2 = IMP[c2 * 64 + q];
#pragma unroll
            for (int k = 0; k < 8; ++k) cnt[k] += ((v2 > val[k]) || (v2 == val[k] && c2 < cg * 8 + k)) ? 1 : 0; }
        unsigned bits = 0u;
#pragma unroll
        for (int k = 0; k < 8; ++k) { const int c = cg * 8 + k; const bool s_ = (c == 0) || (c == i) || (c == i - 1) || (c >= 1 && c <= i - 2 && cnt[k] < 13); bits |= s_ ? (1u << k) : 0u; }
        if (bits) __hip_atomic_fetch_or((LAS unsigned*)(lds + L_SEL) + q * 2 + (cg >> 2), bits << ((cg & 3) * 8), __ATOMIC_RELAXED, __HIP_MEMORY_SCOPE_WORKGROUP);
        LDS_WAIT(); __syncthreads();
        const unsigned lo = ((LAS unsigned*)(lds + L_SEL))[qi * 2], hi = ((LAS unsigned*)(lds + L_SEL))[qi * 2 + 1];
        sel = ((unsigned long long)hi << 32) | lo;
    } else sel = (1ull << (i + 1)) - 1ull;
    const int nslc = i + 1, nslc2 = (nslc + 1) & ~1, w0 = i - 8 < 0 ? 0 : i - 8, nwin = i - w0 + 1, n2 = nslc2 + ((nwin + 1) & ~1);
    const bf16* KS = (const bf16*)(ws + WS_KSB) + (size_t)bg * SEQ * 64; const bf16* VS = (const bf16*)(ws + WS_VST) + (size_t)bg * 64 * SEQ;
    const bf16* KW = (const bf16*)(ws + WS_KWB) + (size_t)bg * SEQ * 64; const bf16* VW = (const bf16*)(ws + WS_VWT) + (size_t)bg * 64 * SEQ;
#define AT_TILE(s, isw, j, valid) const bool isw = (s) >= nslc2; const int j = isw ? w0 + ((s) - nslc2) : (s); const bool valid = (s) < n2 && (isw ? ((s) - nslc2) < nwin : (s) < nslc)
#define AT_LOAD(s) do { AT_TILE(s, w_, j_, v_); if (v_) { TileSrc t_{(w_ ? KW : KS) + (size_t)j_ * 64 * 64, (w_ ? VW : VS) + j_ * 64, SEQ}; tile_load(t_, tid, kr, vr); } } while (0)
#define AT_STORE(s) do { AT_TILE(s, w_, j_, v_); if (v_) tile_store(lds, (s) & 3, tid, kr, vr); } while (0)
#define AT_COMPUTE(s) do { AT_TILE(s, isw, j, v_); if (v_) { \
        const bool general = ((i - j) <= 2) || (isw && j == i - 8); const bool lane_on = isw ? true : (((sel >> j) & 1ull) != 0ull); const int sl = (s) & 3; \
        if (general) { const int khi = (j == i) ? qi : 63, klo = (isw && j == i - 8) ? qi : 0; \
            att_step<3, 1>(lds + L_KBUF + sl * TILE_B, lds + L_VBUF + sl * TILE_B, qf, cnear, lane_on, klo, khi, 64 * (i - j), qi, btab, hidx, o, lsum, impacc, lane); } \
        else { const float cfar[3] = {btab[hidx[0] * BT_PITCH + 128] - B2, btab[hidx[1] * BT_PITCH + 128] - B2, btab[hidx[2] * BT_PITCH + 128] - B2};     \
            att_step<3, 0>(lds + L_KBUF + sl * TILE_B, lds + L_VBUF + sl * TILE_B, qf, cfar, lane_on, 0, 63, 0, qi, btab, hidx, o, lsum, impacc, lane); } } } while (0)
    AT_LOAD(0); AT_STORE(0); AT_LOAD(1); AT_STORE(1); LDS_WAIT(); __syncthreads();
#pragma unroll 1
    for (int s = 0; s < n2; s += 2) {
        if (s == nslc2) AT_FINALIZE(1);
#pragma unroll 1
        for (int h2 = 0; h2 < 2; ++h2) { AT_LOAD(s + 2 + h2); AT_COMPUTE(s + h2); AT_STORE(s + 2 + h2); }
        LDS_WAIT(); __syncthreads();
    }
#undef AT_TILE
#undef AT_LOAD
#undef AT_STORE
#undef AT_COMPUTE
    AT_FINALIZE(2);
#undef AT_FINALIZE
    const unsigned moff = (unsigned)(row * DM + hb * 64 + 4 * fq) * 2u;
#pragma unroll
    for (int r = 0; r < 3; ++r)
#pragma unroll
        for (int db = 0; db < 4; ++db) *(v2u*)((char*)(ws + WS_MIX) + moff + (unsigned)(r * 64 + db * 16) * 2u) = out[r][db];
}

__device__ __forceinline__ void mem_unit(Frame& F, int layer, int b, int h, int qblk, float B2m) {
    int tid = F.tid; asm volatile("" : "+v"(tid));
    const int lane = tid & 63, w = F.wave, rho = lane & 15, fq = lane >> 4;
    const int row = b * SEQ + 128 * qblk + 16 * w + rho;
    LAS unsigned char* lds = F.lds; unsigned char* ws = F.ws;
    const bf16* Xq = (const bf16*)(ws + WS_XQB) + (size_t)row * 256 + h * 64 + fq * 8;
    bf16x8 qf[1][2]; qf[0][0] = *(const bf16x8*)Xq; qf[0][1] = *(const bf16x8*)(Xq + 32);
    const int hidx[1] = {0}; const float cinit[1] = {-B2m}; f32x4 o[1][4], impacc[4]; float lsum[1] = {0.f};
#pragma unroll
    for (int db = 0; db < 4; ++db) { o[0][db] = splat4(0.f); impacc[db] = splat4(0.f); }
    const bf16* K = (const bf16*)(ws + WS_MKB) + ((size_t)(layer * 32 + b * 4 + h) * NMEM) * 64; const bf16* V = (const bf16*)(ws + WS_MVT) + ((size_t)(layer * 32 + b * 4 + h) * 64) * NMEM;
    v4u kr, vr;
    { TileSrc t0{K, V, NMEM}; tile_load(t0, tid, kr, vr); tile_store(lds, 0, tid, kr, vr); LDS_WAIT(); __syncthreads(); }
#pragma unroll 1
    for (int s = 0; s < 4; ++s) {
        if (s + 1 < 4) { TileSrc t1{K + (size_t)(s + 1) * 64 * 64, V + (s + 1) * 64, NMEM}; tile_load(t1, tid, kr, vr); }
        att_step<1, 0>(lds + L_KBUF + (s & 1) * TILE_B, lds + L_VBUF + (s & 1) * TILE_B, qf, cinit, true, 0, 63, 0, 0, (const LAS float*)nullptr, hidx, o, lsum, impacc, lane);
        if (s + 1 < 4) tile_store(lds, (s + 1) & 1, tid, kr, vr);
        LDS_WAIT(); __syncthreads();
    }
    const float l = fq_sum(lsum[0]); const float inv = 1.0f / l;
    bf16* mix = (bf16*)(ws + WS_MIX) + (size_t)row * DM + 768 + h * 64 + 4 * fq;
#pragma unroll
    for (int db = 0; db < 4; ++db) { v2u wv; wv.x = cvt_pk_bf16(o[0][db][0] * inv, o[0][db][1] * inv); wv.y = cvt_pk_bf16(o[0][db][2] * inv, o[0][db][3] * inv); *(v2u*)(mix + db * 16) = wv; }
}

__device__ __forceinline__ void mem_unit4(Frame& F, int layer, int b, int h, int qblk0, float B2m) {
    int tid = F.tid; asm volatile("" : "+v"(tid));
    const int lane = tid & 63, w = F.wave, rho = lane & 15, fq = lane >> 4;
    LAS unsigned char* lds = F.lds; unsigned char* ws = F.ws;
    const bf16* K = (const bf16*)(ws + WS_MKB) + ((size_t)(layer * 32 + b * 4 + h) * NMEM) * 64; const bf16* V = (const bf16*)(ws + WS_MVT) + ((size_t)(layer * 32 + b * 4 + h) * 64) * NMEM;
    __syncthreads();
    { v4u kr[4], vr[4];
#pragma unroll
      for (int s = 0; s < 4; ++s) { TileSrc t{K + (size_t)s * 64 * 64, V + s * 64, NMEM}; tile_load(t, tid, kr[s], vr[s]); }
#pragma unroll
      for (int s = 0; s < 4; ++s) tile_store(lds, s, tid, kr[s], vr[s]);
      LDS_WAIT(); __syncthreads(); }
#pragma unroll 1
    for (int u4 = 0; u4 < 4; ++u4) {
        const int row = b * SEQ + 128 * (qblk0 + u4) + 16 * w + rho;
        const bf16* Xq = (const bf16*)(ws + WS_XQB) + (size_t)row * 256 + h * 64 + fq * 8;
        bf16x8 qf[1][2]; qf[0][0] = *(const bf16x8*)Xq; qf[0][1] = *(const bf16x8*)(Xq + 32);
        const int hidx[1] = {0}; const float cinit[1] = {-B2m}; f32x4 o[1][4], impacc[4]; float lsum[1] = {0.f};
#pragma unroll
        for (int db = 0; db < 4; ++db) { o[0][db] = splat4(0.f); impacc[db] = splat4(0.f); }
#pragma unroll
        for (int s = 0; s < 4; ++s)
            att_step<1, 0>(lds + L_KBUF + s * TILE_B, lds + L_VBUF + s * TILE_B, qf, cinit, true, 0, 63, 0, 0, (const LAS float*)nullptr, hidx, o, lsum, impacc, lane);
        const float l = fq_sum(lsum[0]); const float inv = 1.0f / l;
        bf16* mix = (bf16*)(ws + WS_MIX) + (size_t)row * DM + 768 + h * 64 + 4 * fq;
#pragma unroll
        for (int db = 0; db < 4; ++db) { v2u wv; wv.x = cvt_pk_bf16(o[0][db][0] * inv, o[0][db][1] * inv); wv.y = cvt_pk_bf16(o[0][db][2] * inv, o[0][db][3] * inv); *(v2u*)(mix + db * 16) = wv; }
    }
    LDS_WAIT(); __syncthreads();
}
}

namespace sm {
constexpr int W_QS = 0, W_PS = 1536, W_BYTES = 3584;
constexpr int S_PL = NWAVES * W_BYTES;
constexpr int S_LP = S_PL + 2 * 6 * 256 * 4, S_OP = S_LP + 2 * 4 * 8 * 4, S_SEL = S_OP + 2 * 4 * 6 * 64 * 4, S_ACC = S_SEL + 2 * 32 * 4, S_ACCL = S_ACC + 2 * 3 * 6 * 64 * 4, S_IMPS = S_ACCL + 2 * 3 * 8 * 4, S_CNT = S_IMPS + 2 * 256 * 4, S_END = S_CNT + 16;
static_assert(S_END <= 77824, "sample attention LDS map");

__device__ __forceinline__ float wsum_dpp(float x) {
    x += __builtin_bit_cast(float, __builtin_amdgcn_mov_dpp(__builtin_bit_cast(int, x), 0x128, 0xf, 0xf, false));
    x += __builtin_bit_cast(float, __builtin_amdgcn_mov_dpp(__builtin_bit_cast(int, x), 0x124, 0xf, 0xf, false));
    x += __builtin_bit_cast(float, __builtin_amdgcn_mov_dpp(__builtin_bit_cast(int, x), 0x122, 0xf, 0xf, false));
    x += __builtin_bit_cast(float, __builtin_amdgcn_mov_dpp(__builtin_bit_cast(int, x), 0x121, 0xf, 0xf, false));
    const int xi = __builtin_bit_cast(int, x);
    return (__builtin_bit_cast(float, __builtin_amdgcn_readlane(xi, 0)) + __builtin_bit_cast(float, __builtin_amdgcn_readlane(xi, 16))) + (__builtin_bit_cast(float, __builtin_amdgcn_readlane(xi, 32)) + __builtin_bit_cast(float, __builtin_amdgcn_readlane(xi, 48)));
}

template <int NH>
__device__ __forceinline__ void chunk_fb(const float* kb, const float* vb, int stride, int jlo, int jhi, const float (&bias2)[NH], const LAS float* qs, LAS float* ps,
                                         float (&lacc)[NH], float (&oacc)[NH], int lane, float (&pout)[NH]) {
    const int jr = lane < jlo ? jlo : (lane > jhi ? jhi : lane); const bool valid = (lane >= jlo) && (lane <= jhi);
    typedef const __attribute__((address_space(1))) char* gcp_t; gcp_t kbs, vbs;
    { const unsigned long long a = (unsigned long long)kb, c = (unsigned long long)vb;
      kbs = (gcp_t)(((unsigned long long)(unsigned)__builtin_amdgcn_readfirstlane((int)(a >> 32)) << 32) | (unsigned)__builtin_amdgcn_readfirstlane((int)a));
      vbs = (gcp_t)(((unsigned long long)(unsigned)__builtin_amdgcn_readfirstlane((int)(c >> 32)) << 32) | (unsigned)__builtin_amdgcn_readfirstlane((int)c)); }
    stride = __builtin_amdgcn_readfirstlane(stride); jlo = __builtin_amdgcn_readfirstlane(jlo); jhi = __builtin_amdgcn_readfirstlane(jhi);
    const unsigned koff = (unsigned)(jr * stride) * 4u, voff = (unsigned)lane * 4u;
    f32x4 kreg[16];
#pragma unroll
    for (int d4 = 0; d4 < 16; ++d4) kreg[d4] = *(const __attribute__((address_space(1))) f32x4*)(kbs + koff + d4 * 16);
    float s[NH];
#pragma unroll
    for (int h = 0; h < NH; ++h) s[h] = 0.f;
#pragma unroll
    for (int d4 = 0; d4 < 16; ++d4) { const f32x4 k4 = kreg[d4];
#pragma unroll
        for (int h = 0; h < NH; ++h) { const f32x4 q4 = *(const LAS f32x4*)(qs + h * 64 + d4 * 4); s[h] += (k4[0] * q4[0] + k4[1] * q4[1]) + (k4[2] * q4[2] + k4[3] * q4[3]); }
        if ((d4 & 3) == 3) asm volatile("" ::: "memory"); }
#pragma unroll
    for (int h = 0; h < NH; ++h) { const float p = valid ? __builtin_amdgcn_exp2f(s[h] + bias2[h]) : 0.f; pout[h] = p; lacc[h] += wsum_dpp(p); ps[lane * 8 + h] = p; }
    LDS_WAIT();
    constexpr int PVG = 32;
#pragma unroll 1
    for (int j0 = 0; j0 < 64; j0 += PVG) {
        if (j0 > jhi || j0 + PVG - 1 < jlo) continue;
        float vv[PVG];
#pragma unroll
        for (int q = 0; q < PVG; ++q) { const int j = j0 + q, jj = j < jlo ? jlo : (j > jhi ? jhi : j); vv[q] = *(const __attribute__((address_space(1))) float*)(vbs + (size_t)(jj * stride) * 4u + voff); }
        __builtin_amdgcn_sched_barrier(0);
#pragma unroll
        for (int q = 0; q < PVG; ++q) { const float v = vv[q]; const LAS float* pp = ps + (j0 + q) * 8;
            const f32x4 pa = *(const LAS f32x4*)pp;
            if (NH > 4) { const f32x4 pb = *(const LAS f32x4*)(pp + 4);
#pragma unroll
                for (int h = 4; h < NH; ++h) oacc[h] += pb[h - 4] * v; }
#pragma unroll
            for (int h = 0; h < (NH < 4 ? NH : 4); ++h) oacc[h] += pa[h] * v; }
        __builtin_amdgcn_sched_barrier(0);
    }
    LDS_WAIT();
}

template <int NH>
__device__ __forceinline__ void load_q(const float* q, LAS float* qs, int lane) { float t[NH];
#pragma unroll
    for (int h = 0; h < NH; ++h) t[h] = q[h * 64 + lane];
#pragma unroll
    for (int h = 0; h < NH; ++h) qs[h * 64 + lane] = t[h] * QSCALE_;
    LDS_WAIT(); }

__device__ __forceinline__ void nsa_sample(Frame& F, const LAS float* btab, float B2) {
    int tid = F.tid; asm volatile("" : "+v"(tid));
    const int lane = tid & 63, w = F.wave;
    LAS unsigned char* lds = F.lds; unsigned char* ws = F.ws;
    LAS float* qs = (LAS float*)(lds + w * W_BYTES + W_QS); LAS float* ps = (LAS float*)(lds + w * W_BYTES + W_PS);
    LAS float* PL = (LAS float*)(lds + S_PL); LAS float* LP = (LAS float*)(lds + S_LP); LAS float* OP = (LAS float*)(lds + S_OP); LAS int* SELL = (LAS int*)(lds + S_SEL);
    LAS float* ACC = (LAS float*)(lds + S_ACC); LAS float* ACCL = (LAS float*)(lds + S_ACCL);
    const float* Qf = (const float*)(ws + WS_Q); const float* Gf = (const float*)(ws + WS_G);
    const float* KCs = (const float*)(ws + WS_KC) + (size_t)CMP_ROWS_P * 64; const float* VCs = KCs + (size_t)CMP_ROWS * 64;
    const float* ck = FIN(F, I_CKV); const int* pt = (const int*)F.in[I_PT]; const float* cwin = FIN(F, I_CWIN);
#pragma unroll 1
    for (int rb = blockIdx.x; rb * 2 < MS * 2; rb += F.G) {
#ifndef NO_STAGEA
        {
            const int u = w >> 2, wq = w & 3, U = rb * 2 + u, rs = U >> 1, g = U & 1, b = rs >> 3, tl = rs & 7, t = PAST + tl, row = MP + rs;
            load_q<6>(Qf + (size_t)row * 768 + g * 384, qs, lane);
            const int c = wq * 64 + lane; int dist = t - (c * 64 + 63); dist = dist > 128 ? 128 : dist;
            float bias2[6], lacc[6], oacc[6], pout[6];
#pragma unroll
            for (int h = 0; h < 6; ++h) { bias2[h] = btab[(g * 6 + h) * 132 + dist] - B2; lacc[h] = 0.f; oacc[h] = 0.f; }
            const float* kb = KCs + ((size_t)(b * 256 + wq * 64) * 2 + g) * 64;
            chunk_fb<6>(kb, kb + (VCs - KCs), 128, 0, 63, bias2, qs, ps, lacc, oacc, lane, pout);
#pragma unroll
            for (int h = 0; h < 6; ++h) { PL[(u * 6 + h) * 256 + c] = pout[h]; OP[((u * 4 + wq) * 6 + h) * 64 + lane] = oacc[h]; if (lane == 0) LP[(u * 4 + wq) * 8 + h] = lacc[h]; }
            for (int k = tid; k < 2 * 3 * 6 * 64; k += NWAVES * 64) ACC[k] = 0.f;
            if (tid < 2 * 3 * 8) ACCL[tid] = 0.f;
        }
#endif
        LDS_WAIT(); __syncthreads();
        {
            const int u = w >> 2, wq = w & 3, U = rb * 2 + u, rs = U >> 1, g = U & 1, row = MP + rs, c = wq * 64 + lane;
            LAS float* IMPS = (LAS float*)(lds + S_IMPS); LAS int* CNT = (LAS int*)(lds + S_CNT);
            float il[6], imp = 0.f;
#pragma unroll
            for (int h = 0; h < 6; ++h) { const float l = LP[(u * 4 + 0) * 8 + h] + LP[(u * 4 + 1) * 8 + h] + LP[(u * 4 + 2) * 8 + h] + LP[(u * 4 + 3) * 8 + h]; il[h] = 1.0f / l; imp += PL[(u * 6 + h) * 256 + c] * il[h]; }
            IMPS[u * 256 + c] = imp;
            if (wq == 0) {
#pragma unroll
                for (int h = 0; h < 6; ++h) { const float o = OP[((u * 4 + 0) * 6 + h) * 64 + lane] + OP[((u * 4 + 1) * 6 + h) * 64 + lane] + OP[((u * 4 + 2) * 6 + h) * 64 + lane] + OP[((u * 4 + 3) * 6 + h) * 64 + lane];
                    ACC[((u * 3 + 0) * 6 + h) * 64 + lane] = Gf[(size_t)row * 64 + (g * 6 + h) * 3 + 0] * o * il[h]; }
                if (lane == 0) { SELL[u * 32 + 0] = 0; SELL[u * 32 + 1] = 255; CNT[u] = 0; }
                if (lane < 15) { const int j0_ = lane == 1 ? 255 : 0; const int pg = pt[(rs >> 3) * NPAGES + (j0_ >> 1)]; if (lane >= 2) SELL[u * 32 + lane] = -1; SELL[u * 32 + 16 + lane] = pg; }
            }
            LDS_WAIT(); __syncthreads();
            int cnt = 0;
#pragma unroll 8
            for (int c4 = 0; c4 < 256; c4 += 4) { const f32x4 v4 = *(const LAS f32x4*)(IMPS + u * 256 + c4);
#pragma unroll
                for (int e = 0; e < 4; ++e) { const int c2 = c4 + e; const bool cand = (c2 >= 1) && (c2 <= 254); cnt += (cand && ((v4[e] > imp) || (v4[e] == imp && c2 < c))) ? 1 : 0; } }
            if (c >= 1 && c <= 254 && cnt < 13) { const int slot = __hip_atomic_fetch_add(CNT + u, 1, __ATOMIC_RELAXED, __HIP_MEMORY_SCOPE_WORKGROUP); SELL[u * 32 + 2 + slot] = c; SELL[u * 32 + 18 + slot] = pt[(rs >> 3) * NPAGES + (c >> 1)]; }
        }
        LDS_WAIT(); __syncthreads();
#ifndef NO_STAGEB
        {
            struct SbTask { const float* kb; const float* vb; int stride, jlo, jhi, pos0, br, u, g, t; bool dead; };
            auto sb_task = [&](int tk) -> SbTask { SbTask T; const int u = tk / 25, k = tk % 25, U = rb * 2 + u, rs = U >> 1, g = U & 1, b = rs >> 3, tl = rs & 7;
                T.u = u; T.g = g; T.t = PAST + tl; T.jlo = 0; T.jhi = 63; T.dead = false;
                if (k < 15) { int j = __builtin_amdgcn_readfirstlane(SELL[u * 32 + k]); T.br = 1; if (j < 0) { T.dead = true; j = 0; }
                    const int page = __builtin_amdgcn_readfirstlane(SELL[u * 32 + 16 + k]); T.kb = ck + (((size_t)page * PAGE + (j & 1) * 64) * 4 + 2) * 128 + g * 64; T.stride = 512; T.pos0 = j * 64; }
                else if (k == 15) { T.br = 1; T.kb = F.out + O_KVS + (((size_t)b * DSEQ) * 4 + 2) * 128 + g * 64; T.stride = 512; T.pos0 = PAST; T.jhi = tl; }
                else if (k < 24) { T.br = 2; const int r0 = (k - 16) * 64; T.kb = cwin + ((size_t)b * 512 + r0) * 256 + g * 64; T.stride = 256; T.pos0 = PAST - 512 + r0; T.jlo = tl > r0 ? tl - r0 : 0; }
                else { T.br = 2; T.kb = F.out + O_WINS + ((size_t)b * 512 + 504) * 256 + g * 64; T.stride = 256; T.pos0 = PAST; T.jhi = tl; }
                T.vb = T.kb + 128; return T; };
            int cur_u = -1; float keep = 0.f;
            SbTask nx = sb_task(w);
#pragma unroll 1
            for (int tk = w; tk < 50; tk += NWAVES) {
                const SbTask T = nx;
                float t0 = 0.f, t1 = 0.f, t2 = 0.f, t3 = 0.f;
                if (tk + NWAVES < 50) { nx = sb_task(tk + NWAVES);
                    const int jr = lane < nx.jlo ? nx.jlo : (lane > nx.jhi ? nx.jhi : lane); const float* kp = nx.kb + (size_t)jr * nx.stride;
                    t0 = kp[0]; t1 = kp[32]; t2 = kp[128]; t3 = kp[160]; }
                if (T.u != cur_u) { const int U = rb * 2 + T.u; load_q<6>(Qf + (size_t)(MP + (U >> 1)) * 768 + T.g * 384, qs, lane); cur_u = T.u; }
                int dist = T.t - (T.pos0 + lane); dist = dist < 0 ? 0 : (dist > 128 ? 128 : dist);
                float bias2[6], lacc[6], oacc[6], pout[6];
#pragma unroll
                for (int h = 0; h < 6; ++h) { bias2[h] = T.dead ? -1e30f : btab[(T.g * 6 + h) * 132 + dist] - B2; lacc[h] = 0.f; oacc[h] = 0.f; }
                chunk_fb<6>(T.kb, T.vb, T.stride, T.jlo, T.jhi, bias2, qs, ps, lacc, oacc, lane, pout);
#pragma unroll
                for (int h = 0; h < 6; ++h) { __hip_atomic_fetch_add(ACC + ((T.u * 3 + T.br) * 6 + h) * 64 + lane, oacc[h], __ATOMIC_RELAXED, __HIP_MEMORY_SCOPE_WORKGROUP); if (lane == 0) __hip_atomic_fetch_add(ACCL + (T.u * 3 + T.br) * 8 + h, lacc[h], __ATOMIC_RELAXED, __HIP_MEMORY_SCOPE_WORKGROUP); }
                keep += (t0 + t1) + (t2 + t3);
            }
            if (keep == 1.2345e33f) ps[lane] = keep;
        }
#endif
        LDS_WAIT(); __syncthreads();
#pragma unroll 1
        for (int pr = w; pr < 12; pr += NWAVES) { const int u = pr / 6, h = pr % 6, U = rb * 2 + u, rs = U >> 1, g = U & 1, row = MP + rs;
            const float* gt = Gf + (size_t)row * 64 + (g * 6 + h) * 3;
            const float o = ACC[((u * 3 + 0) * 6 + h) * 64 + lane] + gt[1] * ACC[((u * 3 + 1) * 6 + h) * 64 + lane] / ACCL[(u * 3 + 1) * 8 + h] + gt[2] * ACC[((u * 3 + 2) * 6 + h) * 64 + lane] / ACCL[(u * 3 + 2) * 8 + h];
            ((bf16*)(ws + WS_MIX))[(size_t)row * DM + g * 384 + h * 64 + lane] = (bf16)(cvt_pk_bf16(o, 0.f) & 0xffffu); }
        LDS_WAIT(); __syncthreads();
    }
}

__device__ __forceinline__ void mem_sample(Frame& F, int layer, float B2m) {
    int tid = F.tid; asm volatile("" : "+v"(tid));
    const int lane = tid & 63, w = F.wave;
    LAS unsigned char* lds = F.lds; unsigned char* ws = F.ws;
    LAS float* qs = (LAS float*)(lds + w * W_BYTES + W_QS); LAS float* ps = (LAS float*)(lds + w * W_BYTES + W_PS);
    LAS float* ACC = (LAS float*)(lds + S_ACC); LAS float* ACCL = (LAS float*)(lds + S_ACCL);
#pragma unroll 1
    for (int tsk = blockIdx.x; tsk < DBATCH * 8; tsk += F.G) { const int b = tsk >> 3, h = (tsk >> 1) & 3, half = tsk & 1, row0 = MP + b * 8 + half * 4;
        if (tid < 4 * 64) ACC[tid] = 0.f; if (tid < 8) ACCL[tid] = 0.f;
        LDS_WAIT(); __syncthreads();
        if (w < 4) {
            const float* xq = (const float*)(ws + WS_XQ) + (size_t)row0 * 256 + h * 64 + lane;
            float t[4];
#pragma unroll
            for (int r = 0; r < 4; ++r) t[r] = xq[r * 256];
#pragma unroll
            for (int r = 0; r < 4; ++r) qs[r * 64 + lane] = t[r] * QSCALE_;
            LDS_WAIT();
            const float* kb = FIN(F, I_CMEM) + (((size_t)layer * DBATCH + b) * NMEM + w * 64) * 512 + h * 64;
            float bias2[4] = {-B2m, -B2m, -B2m, -B2m}, lacc[4] = {0.f, 0.f, 0.f, 0.f}, oacc[4] = {0.f, 0.f, 0.f, 0.f}, pout[4];
            chunk_fb<4>(kb, kb + 256, 512, 0, 63, bias2, qs, ps, lacc, oacc, lane, pout);
#pragma unroll
            for (int r = 0; r < 4; ++r) { __hip_atomic_fetch_add(ACC + r * 64 + lane, oacc[r], __ATOMIC_RELAXED, __HIP_MEMORY_SCOPE_WORKGROUP); if (lane == 0) __hip_atomic_fetch_add(ACCL + r, lacc[r], __ATOMIC_RELAXED, __HIP_MEMORY_SCOPE_WORKGROUP); }
        }
        LDS_WAIT(); __syncthreads();
        if (w < 4) ((bf16*)(ws + WS_MIX))[(size_t)(row0 + w) * DM + 768 + h * 64 + lane] = (bf16)(cvt_pk_bf16(ACC[w * 64 + lane] / ACCL[w], 0.f) & 0xffffu);
        LDS_WAIT(); __syncthreads();
    }
}
}
namespace sg {
typedef short bf16x8 __attribute__((ext_vector_type(8)));
__device__ __forceinline__ v4u ldg16(const void* ubase, unsigned off) { return *(const v4u*)((const char*)ubase + off); }

template <int RW, int MB, int NB>
__device__ __forceinline__ void tile_mm(Frame& F, const bf16* A, int r0, const bf16* Bt, int K, const int (&brow)[NB], f32x4 (&acc)[MB][NB], int tid, int w, int lane) {
    constexpr int KQ = 8 / RW, KS = 4 / KQ, CH = NB / 2;
    const int fr = lane & 15, fq = lane >> 4, rg = w % RW, kq = w / RW;
    LAS unsigned char* lds = F.lds;
    const unsigned a0 = (unsigned)((r0 + 16 * MB * rg + fr) * K + 32 * KS * kq + 8 * fq) * 2u;
    unsigned bsrc[CH], bdst[CH];
#pragma unroll
    for (int i = 0; i < CH; ++i) { const int id = tid * CH + i, n = id >> 4, c16 = id & 15; int br_ = brow[0];
#pragma unroll
        for (int nb = 1; nb < NB; ++nb) br_ = (n >> 4) == nb ? brow[nb] : br_;
        bsrc[i] = (unsigned)((br_ + (n & 15)) * K + c16 * 8) * 2u; bdst[i] = (unsigned)((((n >> 4) * 4 + (c16 >> 2)) * 64 + (n & 15) + 16 * (c16 & 3)) * 16); }
#pragma unroll
    for (int mb = 0; mb < MB; ++mb)
#pragma unroll
        for (int nb = 0; nb < NB; ++nb) acc[mb][nb] = (f32x4){0.f, 0.f, 0.f, 0.f};
    const int nst = K / 128;
    constexpr int D = 6, DB = 3;
    v4u ring[D][KS * MB];
#define SG_LDA(dst, s_) do { const unsigned o_ = (unsigned)((s_) < nst ? (s_) : nst - 1) * 256u; _Pragma("unroll") for (int mb = 0; mb < MB; ++mb) _Pragma("unroll") for (int j = 0; j < KS; ++j) dst[KS * mb + j] = ldg16(A, a0 + (unsigned)(16 * mb * K) * 2u + o_ + 64u * j); } while (0)
#pragma unroll
    for (int q = 0; q < D; ++q) SG_LDA(ring[q], q);
    v4u br[DB][CH];
#pragma unroll
    for (int j = 0; j < DB; ++j)
#pragma unroll
        for (int i = 0; i < CH; ++i) br[j][i] = ldg16(Bt, bsrc[i] + (unsigned)j * 256u);
#pragma unroll
    for (int i = 0; i < CH; ++i) *(LAS v4u*)(lds + bdst[i]) = br[0][i];
#pragma unroll
    for (int i = 0; i < CH; ++i) br[0][i] = ldg16(Bt, bsrc[i] + (unsigned)DB * 256u);
    LDS_WAIT(); __syncthreads();
#pragma unroll 1
    for (int s0 = 0; s0 < nst; s0 += D) {
#pragma unroll
        for (int q = 0; q < D; ++q) { const int s = s0 + q;
          if (s < nst) {
            const LAS unsigned char* bb = lds + (s & 1) * 16384 + kq * (KS * 1024) + lane * 16;
            bf16x8 af[KS * MB];
#pragma unroll
            for (int k = 0; k < KS * MB; ++k) af[k] = __builtin_bit_cast(bf16x8, ring[q][k]);
            SG_LDA(ring[q], s + D);
#pragma unroll
            for (int nb = 0; nb < NB; ++nb)
#pragma unroll
                for (int j = 0; j < KS; ++j) { const bf16x8 bf = *(const LAS bf16x8*)(bb + (nb * 4 + j) * 1024);
#pragma unroll
                    for (int mb = 0; mb < MB; ++mb) acc[mb][nb] = __builtin_amdgcn_mfma_f32_16x16x32_bf16(bf, af[KS * mb + j], acc[mb][nb], 0, 0, 0); }
            if (s + 1 < nst) {
#pragma unroll
                for (int i = 0; i < CH; ++i) *(LAS v4u*)(lds + ((s + 1) & 1) * 16384 + bdst[i]) = br[(q + 1) % DB][i];
                if (s + 1 + DB < nst) {
#pragma unroll
                    for (int i = 0; i < CH; ++i) br[(q + 1) % DB][i] = ldg16(Bt, bsrc[i] + (unsigned)(s + 1 + DB) * 256u); }
            }
            LDS_WAIT(); __syncthreads();
          }
        }
    }
#undef SG_LDA
    if (kq > 0) {
#pragma unroll
        for (int mb = 0; mb < MB; ++mb)
#pragma unroll
            for (int nb = 0; nb < NB; ++nb) *(LAS f32x4*)(lds + 32768 + (((((kq - 1) * RW + rg) * MB + mb) * NB + nb) * 64 + lane) * 16) = acc[mb][nb];
    }
    LDS_WAIT(); __syncthreads();
    if (kq == 0) {
#pragma unroll
        for (int p = 0; p < KQ - 1; ++p)
#pragma unroll
            for (int mb = 0; mb < MB; ++mb)
#pragma unroll
                for (int nb = 0; nb < NB; ++nb) acc[mb][nb] += *(const LAS f32x4*)(lds + 32768 + ((((p * RW + rg) * MB + mb) * NB + nb) * 64 + lane) * 16);
    }
}

template <bool BASEB>
__device__ __forceinline__ void resid(Frame& F, const bf16* A, const bf16* Bt, int K, const float* baseS, const bf16* baseB, float* outF, bf16* outB, float* ssq) {
    int tid = F.tid; asm volatile("" : "+v"(tid)); const int lane = tid & 63, w = F.wave, fr = lane & 15, fq = lane >> 4;
#pragma unroll 1
    for (int t = blockIdx.x; t < 256; t += F.G) { const int tn = t >> 3, mq = t & 7;
        int brow[2];
#pragma unroll
        for (int nb = 0; nb < 2; ++nb) brow[nb] = 32 * tn + 16 * nb;
        f32x4 acc[1][2];
        tile_mm<2, 1, 2>(F, A, MP + 32 * mq, Bt, K, brow, acc, tid, w, lane);
        if (w < 2) { const int rs = 32 * mq + 16 * w + fr, row = MP + rs; float ss = 0.f;
#pragma unroll
            for (int nb = 0; nb < 2; ++nb) { const int c = 32 * tn + 16 * nb + 4 * fq; f32x4 b;
                if (BASEB) { const v2u bw = *(const v2u*)(baseB + (size_t)row * DM + c); b = (f32x4){__uint_as_float(bw.x << 16), __uint_as_float(bw.x & 0xffff0000u), __uint_as_float(bw.y << 16), __uint_as_float(bw.y & 0xffff0000u)}; }
                else b = *(const f32x4*)(baseS + (size_t)rs * DM + c);
                const f32x4 y = b + acc[0][nb];
                if (outF) *(f32x4*)(outF + (size_t)row * DM + c) = y;
                if (outB) { v2u wv; wv.x = cvt_pk_bf16(y[0], y[1]); wv.y = cvt_pk_bf16(y[2], y[3]); *(v2u*)(outB + (size_t)row * DM + c) = wv; ss += (y[0] * y[0] + y[1] * y[1]) + (y[2] * y[2] + y[3] * y[3]); } }
            if (outB) { ss = fq_sum(ss); if (fq == 0) atomicAdd(ssq + row, ss); }
        }
    }
}

__device__ __forceinline__ void up(Frame& F, const bf16* A, const bf16* Bt, const float* ssq) {
    int tid = F.tid; asm volatile("" : "+v"(tid)); const int lane = tid & 63, w = F.wave, fr = lane & 15, fq = lane >> 4;
    float* US = (float*)(F.ws + WS_US);
#pragma unroll 1
    for (int t = blockIdx.x; t < NUP / 32; t += F.G) { const int tn = t >> 1, mh = t & 1;
        int brow[4];
#pragma unroll
        for (int nb = 0; nb < 4; ++nb) brow[nb] = 64 * tn + 16 * nb;
        f32x4 acc[2][4];
        tile_mm<4, 2, 4>(F, A, MP + 128 * mh, Bt, DM, brow, acc, tid, w, lane);
        if (w < 4) {
#pragma unroll
            for (int mb = 0; mb < 2; ++mb) { const int rs = 128 * mh + 32 * w + 16 * mb + fr; const float rstd = rsqrtf(ssq[MP + rs] * (1.0f / DM) + EPS);
#pragma unroll
                for (int nb = 0; nb < 4; ++nb) { const int n = 64 * tn + 16 * nb + 4 * fq, chn = ((n >> 7) & 1) * DFF + 128 * (n >> 8) + (n & 127); *(f32x4*)(US + (size_t)rs * NUP + chn) = acc[mb][nb] * rstd; }
            }
        }
    }
}

__device__ __forceinline__ void in1(Frame& F, const float* ssq) {
    int tid = F.tid; asm volatile("" : "+v"(tid)); const int lane = tid & 63, w = F.wave, fr = lane & 15, fq = lane >> 4;
    unsigned char* ws = F.ws;
#pragma unroll 1
    for (int t = blockIdx.x; t < 128; t += F.G) { const int th = t >> 3, mq = t & 7, pn = th >> 2, wc = th & 3;
        int brow[4];
#pragma unroll
        for (int nb = 0; nb < 4; ++nb) brow[nb] = 256 * pn + 128 * (nb >> 1) + 32 * wc + 16 * (nb & 1);
        f32x4 acc[1][4];
        tile_mm<2, 1, 4>(F, (const bf16*)(ws + WS_Y2B), MP + 32 * mq, (const bf16*)(ws + WS_WIN1), DM, brow, acc, tid, w, lane);
        if (w < 2) { const int rs = 32 * mq + 16 * w + fr, row = MP + rs; const float rstd = rsqrtf(ssq[row] * (1.0f / DM) + EPS);
            f32x4 z[4]; float ss = 0.f;
#pragma unroll
            for (int nb = 0; nb < 4; ++nb) { z[nb] = acc[0][nb] * rstd; ss += (z[nb][0] * z[nb][0] + z[nb][1] * z[nb][1]) + (z[nb][2] * z[nb][2] + z[nb][3] * z[nb][3]); }
            if (pn < 3) {
#pragma unroll
                for (int nb = 0; nb < 4; ++nb) { const int c = 256 * pn + 64 * wc + 16 * nb + 4 * fq;
                    *(f32x4*)((float*)(ws + WS_UP) + (size_t)row * 768 + c) = z[nb]; *(f32x4*)(F.out + O_POOLS + ((size_t)(rs >> 3) * 15 + 7 + (rs & 7)) * 768 + c) = z[nb]; }
            } else { ss = fq_sum(ss); const float hn = rsqrtf(ss * (1.0f / 64.0f) + EPS);
#pragma unroll
                for (int nb = 0; nb < 4; ++nb) { const int d = 16 * nb + 4 * fq; const f32x4 gx = *(const f32x4*)(FIN(F, I_XQG) + 64 + d); *(f32x4*)((float*)(ws + WS_XQ) + (size_t)row * 256 + wc * 64 + d) = z[nb] * hn * gx; }
            }
        }
    }
}
}

namespace cf {
typedef short bf16x8 __attribute__((ext_vector_type(8)));
constexpr int BBUF = 16384;
template <bool SAMPLE, int D>
__device__ __forceinline__ void cmp_tile(Frame& F, int b, int which, int c0, float* H1) {
    int tid = F.tid; asm volatile("" : "+v"(tid));
    const int lane = tid & 63, w = F.wave, rho = lane & 15, fq = lane >> 4;
    LAS unsigned char* lds = F.lds; unsigned char* ws = F.ws;
    const int c = c0 + 8 * w + (rho >> 1), g = rho & 1;
    const float* src;
    if (SAMPLE) { const int page = ((const int*)F.in[I_PT])[b * NPAGES + (c >> 1)]; src = FIN(F, I_CKV) + (((size_t)page * PAGE + (c & 1) * 64) * 4 + which) * 128 + g * 64 + 8 * fq; }
    else src = F.out + O_KVP + (((size_t)b * SEQ + c * 64) * 4 + which) * 128 + g * 64 + 8 * fq;
    const bf16* Bt = (const bf16*)(ws + WS_WC1B) + (size_t)which * 256 * 4096;
    unsigned bsrc[2], bdst[2];
#pragma unroll
    for (int i = 0; i < 2; ++i) { const int id = tid * 2 + i, h = id >> 3, c8 = id & 7; bsrc[i] = (unsigned)(h * 4096 + c8 * 8) * 2u; bdst[i] = (unsigned)((((h >> 4) * 2 + (c8 >> 2)) * 64 + (h & 15) + 16 * (c8 & 3)) * 16); }
    f32x4 acc[8];
#pragma unroll
    for (int nb = 0; nb < 8; ++nb) acc[nb] = (f32x4){0.f, 0.f, 0.f, 0.f};
    f32x4 ar[D][4];
#define CF_LD4(p__) (SAMPLE ? __builtin_nontemporal_load((const f32x4*)(p__)) : *(const f32x4*)(p__))
#define CF_LDA(dst, l_) do { const float* p_ = src + (size_t)((l_) < 64 ? (l_) : 63) * 512; dst[0] = CF_LD4(p_); dst[1] = CF_LD4(p_ + 4); dst[2] = CF_LD4(p_ + 32); dst[3] = CF_LD4(p_ + 36); } while (0)
#pragma unroll
    for (int q = 0; q < D - 1; ++q) CF_LDA(ar[q], q);
    v4u br[2];
#pragma unroll
    for (int i = 0; i < 2; ++i) br[i] = *(const v4u*)((const char*)Bt + bsrc[i]);
#pragma unroll
    for (int i = 0; i < 2; ++i) *(LAS v4u*)(lds + bdst[i]) = br[i];
    LDS_WAIT(); __syncthreads();
#pragma unroll
    for (int i = 0; i < 2; ++i) br[i] = *(const v4u*)((const char*)Bt + bsrc[i] + 128u);
#pragma unroll 1
    for (int l0 = 0; l0 < 64; l0 += D) {
#pragma unroll
        for (int q = 0; q < D; ++q) { const int l = l0 + q;
            const LAS unsigned char* bb = lds + (l & 1) * BBUF + lane * 16;
            bf16x8 af[2];
#pragma unroll
            for (int ks = 0; ks < 2; ++ks) { v4u t; t.x = cvt_pk_bf16(ar[q][2 * ks][0], ar[q][2 * ks][1]); t.y = cvt_pk_bf16(ar[q][2 * ks][2], ar[q][2 * ks][3]); t.z = cvt_pk_bf16(ar[q][2 * ks + 1][0], ar[q][2 * ks + 1][1]); t.w = cvt_pk_bf16(ar[q][2 * ks + 1][2], ar[q][2 * ks + 1][3]);
                af[ks] = __builtin_bit_cast(bf16x8, t); }
            CF_LDA(ar[(q + D - 1) % D], l + D - 1);
#pragma unroll
            for (int nb = 0; nb < 8; ++nb)
#pragma unroll
                for (int ks = 0; ks < 2; ++ks) { const bf16x8 bf = *(const LAS bf16x8*)(bb + (nb * 2 + ks) * 1024); acc[nb] = __builtin_amdgcn_mfma_f32_16x16x32_bf16(bf, af[ks], acc[nb], 0, 0, 0); }
            if (l + 1 < 64) {
#pragma unroll
                for (int i = 0; i < 2; ++i) *(LAS v4u*)(lds + ((l + 1) & 1) * BBUF + bdst[i]) = br[i];
                if (l + 2 < 64) {
#pragma unroll
                    for (int i = 0; i < 2; ++i) br[i] = *(const v4u*)((const char*)Bt + bsrc[i] + (unsigned)(l + 2) * 128u); }
            }
            LDS_WAIT(); __syncthreads();
        }
    }
#undef CF_LDA
#undef CF_LD4
    const int row = SAMPLE ? CMP_ROWS_P + (b * 256 + c) * 2 + g : (b * 64 + c) * 2 + g;
    const float* b1 = FIN(F, I_CB1) + which * 128; const float* b1e = (const float*)(ws + WS_CTL) + CW_B1EFF + which * 128;
    float* dst = H1 + ((size_t)which * CMP_ROWS + row) * 128 + 4 * fq;
    f32x4 bb[8];
#pragma unroll
    for (int nb = 0; nb < 8; ++nb) bb[nb] = *(const f32x4*)(b1 + 16 * nb + 4 * fq) + *(const f32x4*)(b1e + 16 * nb + 4 * fq);
    __builtin_amdgcn_sched_barrier(0);
#pragma unroll
    for (int nb = 0; nb < 8; ++nb) { f32x4 o;
#pragma unroll
        for (int e = 0; e < 4; ++e) o[e] = gelu_tanh(acc[nb][e] + bb[nb][e]);
        *(f32x4*)(dst + 16 * nb) = o; }
}

__device__ __forceinline__ void cmp_tile_p32(Frame& F, int b, int which, int c0, float* H1) {
    int tid = F.tid; asm volatile("" : "+v"(tid));
    const int lane = tid & 63, w = F.wave, rho = lane & 15, fq = lane >> 4, rg = w & 1, kq = w >> 1;
    LAS unsigned char* lds = F.lds; unsigned char* ws = F.ws;
    const int c = c0 + 8 * rg + (rho >> 1), g = rho & 1;
    const float* src = F.out + O_KVP + (((size_t)b * SEQ + c * 64 + (kq >> 1)) * 4 + which) * 128 + g * 64 + 32 * (kq & 1) + 8 * fq;
    const bf16* Bt = (const bf16*)(ws + WS_WC1B) + (size_t)which * 256 * 4096;
    unsigned bsrc[4], bdst[4];
#pragma unroll
    for (int i = 0; i < 4; ++i) { const int id = tid * 4 + i, n = id >> 4, c16 = id & 15; bsrc[i] = (unsigned)(n * 4096 + c16 * 8) * 2u; bdst[i] = (unsigned)((((n >> 4) * 4 + (c16 >> 2)) * 64 + (n & 15) + 16 * (c16 & 3)) * 16); }
    f32x4 acc[8];
#pragma unroll
    for (int nb = 0; nb < 8; ++nb) acc[nb] = (f32x4){0.f, 0.f, 0.f, 0.f};
    constexpr int NST = 32, D = 4, DB = 2, PBUF = 32768;
    f32x4 ring[D][2];
#define CP_LDA(dst, s_) do { const float* p_ = src + (size_t)((s_) < NST ? (s_) : NST - 1) * 1024; dst[0] = *(const f32x4*)p_; dst[1] = *(const f32x4*)(p_ + 4); } while (0)
#pragma unroll
    for (int q = 0; q < D; ++q) CP_LDA(ring[q], q);
    v4u br[DB][4];
#pragma unroll
    for (int j = 0; j < DB; ++j)
#pragma unroll
        for (int i = 0; i < 4; ++i) br[j][i] = *(const v4u*)((const char*)Bt + bsrc[i] + (unsigned)j * 256u);
#pragma unroll
    for (int i = 0; i < 4; ++i) *(LAS v4u*)(lds + bdst[i]) = br[0][i];
#pragma unroll
    for (int i = 0; i < 4; ++i) br[0][i] = *(const v4u*)((const char*)Bt + bsrc[i] + (unsigned)DB * 256u);
    LDS_WAIT(); __syncthreads();
#pragma unroll 1
    for (int s0 = 0; s0 < NST; s0 += D) {
#pragma unroll
        for (int q = 0; q < D; ++q) { const int s = s0 + q;
            const LAS unsigned char* bb = lds + (s & 1) * PBUF + kq * 1024 + lane * 16;
            v4u t; t.x = cvt_pk_bf16(ring[q][0][0], ring[q][0][1]); t.y = cvt_pk_bf16(ring[q][0][2], ring[q][0][3]); t.z = cvt_pk_bf16(ring[q][1][0], ring[q][1][1]); t.w = cvt_pk_bf16(ring[q][1][2], ring[q][1][3]);
            const bf16x8 af = __builtin_bit_cast(bf16x8, t);
            CP_LDA(ring[q], s + D);
#pragma unroll
            for (int nb = 0; nb < 8; ++nb) { const bf16x8 bf = *(const LAS bf16x8*)(bb + nb * 4096); acc[nb] = __builtin_amdgcn_mfma_f32_16x16x32_bf16(bf, af, acc[nb], 0, 0, 0); }
            if (s + 1 < NST) {
#pragma unroll
                for (int i = 0; i < 4; ++i) *(LAS v4u*)(lds + ((s + 1) & 1) * PBUF + bdst[i]) = br[(q + 1) % DB][i];
                if (s + 1 + DB < NST) {
#pragma unroll
                    for (int i = 0; i < 4; ++i) br[(q + 1) % DB][i] = *(const v4u*)((const char*)Bt + bsrc[i] + (unsigned)(s + 1 + DB) * 256u); }
            }
            LDS_WAIT(); __syncthreads();
        }
    }
#undef CP_LDA
    if (kq > 0) {
#pragma unroll
        for (int nb = 0; nb < 8; ++nb) *(LAS f32x4*)(lds + 65536 + ((((kq - 1) * 2 + rg) * 8 + nb) * 64 + lane) * 16) = acc[nb];
    }
    LDS_WAIT(); __syncthreads();
    if (kq == 0) {
#pragma unroll
        for (int p = 0; p < 3; ++p)
#pragma unroll
            for (int nb = 0; nb < 8; ++nb) acc[nb] += *(const LAS f32x4*)(lds + 65536 + (((p * 2 + rg) * 8 + nb) * 64 + lane) * 16);
        const int row = (b * 64 + c) * 2 + g;
        const float* b1 = FIN(F, I_CB1) + which * 128; const float* b1e = (const float*)(ws + WS_CTL) + CW_B1EFF + which * 128;
        float* dst = H1 + ((size_t)which * CMP_ROWS + row) * 128 + 4 * fq;
        f32x4 bb4[8];
#pragma unroll
        for (int nb = 0; nb < 8; ++nb) bb4[nb] = *(const f32x4*)(b1 + 16 * nb + 4 * fq) + *(const f32x4*)(b1e + 16 * nb + 4 * fq);
        __builtin_amdgcn_sched_barrier(0);
#pragma unroll
        for (int nb = 0; nb < 8; ++nb) { f32x4 o;
#pragma unroll
            for (int e = 0; e < 4; ++e) o[e] = gelu_tanh(acc[nb][e] + bb4[nb][e]);
            *(f32x4*)(dst + 16 * nb) = o; }
    }
}
}
constexpr int ATT_QS = 0, ATT_PS = 1536, ATT_LG = 3584, ATT_WAVE_BYTES = 3584 + 6144, ATT_SHARED = NWAVES * ATT_WAVE_BYTES, ATT_RELB = 100352, ATT_BKT = ATT_RELB + 1536, ATT_BTAB = ATT_BKT + 512, ATT_CONST = ATT_BTAB + 12 * 132 * 4;
static_assert(ATT_SHARED <= ATT_RELB && ATT_CONST + 64 <= RING_BYTES, "attention LDS map");
constexpr float NEGBIG = -1e30f;

__device__ __forceinline__ void attn_tables(Frame& F, int layer) {
    LAS float* relb = (LAS float*)(F.lds + ATT_RELB); LAS int* bkt = (LAS int*)(F.lds + ATT_BKT); LAS float* btab = (LAS float*)(F.lds + ATT_BTAB); LAS float* cst = (LAS float*)(F.lds + ATT_CONST);
    if (F.tid < 384) relb[F.tid] = FIN(F, I_RELB)[F.tid];
    if (F.tid < 128) { const int n = F.tid; int v = n;
        if (n >= 16) { const float nf = (float)n; int lg = 16 + (int)(logf(nf / 16.0f) / 2.0794415416798357f * 16.0f); v = lg > 31 ? 31 : lg; }
        bkt[n] = v; }
    if (F.wave == 7) {
        const float mq = wave_max(fabsf(FIN(F, I_QG)[F.lane])), mk = wave_max(fabsf(FIN(F, I_KG)[F.lane]));
        float mb = 0.f; for (int k = F.lane; k < 384; k += 64) mb = fmaxf(mb, fabsf(FIN(F, I_RELB)[k])); mb = wave_max(mb);
        const float mxq = wave_max(fabsf(FIN(F, I_XQG)[layer * 64 + F.lane])), mxk = wave_max(fabsf(FIN(F, I_XKG)[layer * 64 + F.lane]));
        if (F.lane == 0) { cst[0] = (8.0f * mq * mk + mb) * 1.4426950408889634f; cst[1] = 8.0f * mxq * mxk * 1.4426950408889634f; } }
    __syncthreads();
    for (int k = F.tid; k < 12 * 129; k += NWAVES * 64) { const int h = k / 129, d = k % 129; btab[h * 132 + d] = relb[(d >= 128 ? 31 : bkt[d]) * 12 + h] * 1.4426950408889634f; }
    __syncthreads();
}

__device__ __forceinline__ int vcu_of(Frame& F) { const int bx = blockIdx.x; return (F.G % 8 == 0) ? (bx % 8) * (F.G / 8) + bx / 8 : bx; }

__device__ __forceinline__ void p4_attention0(Frame& F) {
    attn_tables(F, 0);
    const LAS float* btab = (const LAS float*)(F.lds + ATT_BTAB); const float B2 = ((const LAS float*)(F.lds + ATT_CONST))[0], B2m = ((const LAS float*)(F.lds + ATT_CONST))[1];
    sm::nsa_sample(F, btab, B2);
    sm::mem_sample(F, 0, B2m);
    __syncthreads();
#ifndef NO_PROMPT
    const int vcu = vcu_of(F);
#pragma unroll 1
    for (int idx = vcu; idx < 1024; idx += F.G) { const int vc = idx & 255, u4 = idx >> 8, bg = vc >> 4, k = vc & 15; const int i = u4 == 0 ? 63 - k : (u4 == 1 ? 32 + k : (u4 == 2 ? 31 - k : k));
        at::nsa_unit(F, bg >> 1, bg & 1, i, btab, B2); }
#pragma unroll 1
    for (int vc = vcu; vc < 256; vc += F.G) { const int bh = vc >> 3; at::mem_unit4(F, 0, bh >> 2, bh & 3, (vc & 7) * 4, B2m); }
#endif
}

template <int W>
__device__ __forceinline__ void pool_chunk(const float* __restrict__ up  , bf16* __restrict__ mix, int t0  ) {
    float hist[16];
#pragma unroll
    for (int i = 0; i < 16; ++i) hist[i] = (t0 > 0) ? up[(long)(i - 16) * 768] : 0.f;
    float s = 0.f;
#pragma unroll
    for (int i = 16 - (W - 1); i < 16; ++i) s += hist[i];
#pragma unroll 1
    for (int blk = 0; blk < 4; ++blk) {
        float cur[16];
#pragma unroll
        for (int i = 0; i < 16; ++i) cur[i] = up[(long)(blk * 16 + i) * 768];
#pragma unroll
        for (int i = 0; i < 16; ++i) { const int t = t0 + blk * 16 + i;
            s += cur[i];
            const float cnt = (float)((t + 1) < W ? (t + 1) : W);
            mix[(long)(blk * 16 + i) * DM] = (bf16)(cvt_pk_bf16(s / cnt - cur[i], 0.f) & 0xffffu);
            s -= (i - (W - 1) >= 0) ? cur[i - (W - 1)] : hist[16 + i - (W - 1)]; }
#pragma unroll
        for (int i = 0; i < 16; ++i) hist[i] = cur[i];
    }
}

__device__ __forceinline__ void p10_pool_attn(Frame& F) {
    const float* UP = (const float*)(F.ws + WS_UP); const float* sp = FIN(F, I_SPOOL); bf16* MIX = (bf16*)(F.ws + WS_MIX);
#pragma unroll 1
    for (int task = F.gw; task < (MP / 64) * 12; task += F.NGW) { const int chunk = task / 12, strip = task % 12, row0 = chunk * 64, c = strip * 64 + F.lane, grp = strip / 3;
        const float* up = UP + (size_t)row0 * 768 + c; bf16* mix = MIX + (size_t)row0 * DM + c; const int t0 = row0 & 4095;
        if (grp == 0) pool_chunk<2>(up, mix, t0); else if (grp == 1) pool_chunk<4>(up, mix, t0); else if (grp == 2) pool_chunk<8>(up, mix, t0); else pool_chunk<16>(up, mix, t0); }
    { const int total = MS * 192, gt = F.gw * 64 + F.lane, GT = F.NGW * 64;
#pragma unroll 1
      for (int idx = gt; idx < total; idx += GT) { const int rs = idx / 192, c = (idx % 192) * 4, grp = c / 192, w = 2 << grp, row = MP + rs, b = rs >> 3, tl = rs & 7;
        const f32x4 u0 = *(const f32x4*)(UP + (size_t)row * 768 + c); f32x4 s = u0;
        f32x4 pv[15];
#pragma unroll
        for (int j = 1; j < 16; ++j) { const int je = j < w ? j : 0, tt = tl - je; const float* p_ = tt >= 0 ? UP + (size_t)(row - je) * 768 + c : sp + ((size_t)b * 15 + 15 + tt) * 768 + c; pv[j - 1] = *(const f32x4*)p_; }
#pragma unroll
        for (int j = 1; j < 16; ++j) { const float m_ = j < w ? 1.f : 0.f; s += pv[j - 1] * m_; }
        const f32x4 p = s / (float)w - u0;
        v2u o; o.x = cvt_pk_bf16(p[0], p[1]); o.y = cvt_pk_bf16(p[2], p[3]); *(v2u*)(MIX + (size_t)row * DM + c) = o; } }
    attn_tables(F, 1);
    const float B2m = ((const LAS float*)(F.lds + ATT_CONST))[1]; const int vcu = vcu_of(F);
    sm::mem_sample(F, 1, B2m);
    __syncthreads();
#pragma unroll 1
    for (int vc = vcu; vc < 256; vc += F.G) { const int bh = vc >> 3; at::mem_unit4(F, 1, bh >> 2, bh & 3, (vc & 7) * 4, B2m); }
}

#define P7_CONV4(o_) const f32x4 ba_ = *(const f32x4*)(cb + c), bv_ = *(const f32x4*)(cb + DFF + c), wa0_ = *(const f32x4*)(cw + c), wa1_ = *(const f32x4*)(cw + NUP + c), wa2_ = *(const f32x4*)(cw + 2 * NUP + c), \
        wv0_ = *(const f32x4*)(cw + DFF + c), wv1_ = *(const f32x4*)(cw + NUP + DFF + c), wv2_ = *(const f32x4*)(cw + 2 * NUP + DFF + c), \
        xa2_ = *(const f32x4*)(x2 + c), xa1_ = *(const f32x4*)(x1 + c), xa0_ = *(const f32x4*)(x0 + c), xv2_ = *(const f32x4*)(x2 + DFF + c), xv1_ = *(const f32x4*)(x1 + DFF + c), xv0_ = *(const f32x4*)(x0 + DFF + c); \
        _Pragma("unroll") for (int e = 0; e < 4; ++e) { const float ya = ba_[e] + wa0_[e] * xa2_[e] + wa1_[e] * xa1_[e] + wa2_[e] * xa0_[e]; const float yv = bv_[e] + wv0_[e] * xv2_[e] + wv1_[e] * xv1_[e] + wv2_[e] * xv0_[e]; o_[e] = ya * sigmoidf_(ya) * yv; }
__device__ __forceinline__ void p7_fixup(Frame& F, int layer) {
    const float* UB = (const float*)(F.ws + WS_UB); bf16* ACT = (bf16*)(F.ws + WS_ACT);
    const float* cw = FIN(F, I_CONVW) + (size_t)layer * 3 * NUP; const float* cb = FIN(F, I_CONVB) + (size_t)layer * NUP;
    const int total = 128 * 2 * (DFF / 4), gt = F.gw * 64 + F.lane, GT = F.NGW * 64;
    for (int idx = gt; idx < total; idx += GT) { const int c = (idx % (DFF / 4)) * 4, pr = idx / (DFF / 4), pm = pr >> 1, r = pr & 1;
        if ((pm & 15) == 0) continue;
        const float* x0 = UB + ((size_t)pm * 4 + r) * NUP; const float* x1 = r == 0 ? UB + ((size_t)(pm - 1) * 4 + 3) * NUP : UB + ((size_t)pm * 4 + 0) * NUP;
        const float* x2 = r == 0 ? UB + ((size_t)(pm - 1) * 4 + 2) * NUP : UB + ((size_t)(pm - 1) * 4 + 3) * NUP;
        float o[4]; P7_CONV4(o);
        v2u w; w.x = cvt_pk_bf16(o[0], o[1]); w.y = cvt_pk_bf16(o[2], o[3]); *(v2u*)(ACT + (size_t)(pm * 256 + r) * DFF + c) = w; }
    const float* US = (const float*)(F.ws + WS_US); const float* sc = FIN(F, I_SCONV) + (size_t)layer * DBATCH * 2 * NUP; float* cs = F.out + O_CONVS + (size_t)layer * DBATCH * 2 * NUP;
    const int total2 = MS * (DFF / 4);
    for (int idx = gt; idx < total2; idx += GT) { const int c = (idx % (DFF / 4)) * 4, rsi = idx / (DFF / 4), b = rsi >> 3, t8 = rsi & 7;
        const float* x0 = US + (size_t)rsi * NUP; const float* x1 = t8 >= 1 ? x0 - NUP : sc + ((size_t)b * 2 + 1) * NUP; const float* x2 = t8 >= 2 ? x0 - 2 * NUP : sc + ((size_t)b * 2 + t8) * NUP;
        float o[4]; P7_CONV4(o);
        if (t8 >= 6) { *(f32x4*)(cs + ((size_t)b * 2 + (t8 - 6)) * NUP + c) = xa0_; *(f32x4*)(cs + ((size_t)b * 2 + (t8 - 6)) * NUP + DFF + c) = xv0_; }
        v2u w; w.x = cvt_pk_bf16(o[0], o[1]); w.y = cvt_pk_bf16(o[2], o[3]); *(v2u*)(ACT + (size_t)(MP + rsi) * DFF + c) = w; }
}

#ifndef MK_N_LAUNCHES
#define MK_N_LAUNCHES 1
#endif
constexpr int NPH = 15;
constexpr int N_LAUNCHES = MK_N_LAUNCHES;

struct PanelOrder {
    int pm, nN, G, c;
    __device__ __forceinline__ bool next(int i, Unit& u) const { const int L = i * G + c; if (L >= nN) return false; u.pm = pm; u.pn = L; u.kc = 0; return true; }
    __device__ __forceinline__ void a_ready(const Unit&) const {}
    __device__ __forceinline__ void done(const Unit&) const {}
};
struct SplitOrder {
    int pm, nN, nK, G, c;
    __device__ __forceinline__ bool next(int i, Unit& u) const { const int L = i * G + c; if (L >= nN * nK) return false; u.pm = pm; u.pn = L % nN; u.kc = L / nN; return true; }
    __device__ __forceinline__ void a_ready(const Unit&) const {}
    __device__ __forceinline__ void done(const Unit&) const {}
};
struct EpiAtomicF32 {
    static constexpr bool PERM = true, AFTER_DRAIN = false;
    const bf16* baseB; float* outF;
    __device__ __forceinline__ void operator()(const f32x4 (&acc)[2][2][4][2], const Unit& u, int wr, int wc, int fr_in, int fq_in) const {
        int lane_ = fr_in + 16 * fq_in; asm volatile("" : "+v"(lane_)); const int fr = lane_ & 15, fq = lane_ >> 4;
#pragma unroll
        for (int ai = 0; ai < 2; ++ai)
#pragma unroll
            for (int m = 0; m < 4; ++m) { const int row = EPI_ROW(u, ai, wr, m, fr), c0 = u.pn * 128 + wc * 32 + 8 * fq;
                f32x4 y0 = acc[ai][0][m][0], y1 = acc[ai][0][m][1];
                if (u.kc == 0) { const v4u bw = *(const v4u*)((const char*)baseB + (unsigned)(row * DM + c0) * 2u);
                    y0 += (f32x4){__uint_as_float(bw.x << 16), __uint_as_float(bw.x & 0xffff0000u), __uint_as_float(bw.y << 16), __uint_as_float(bw.y & 0xffff0000u)};
                    y1 += (f32x4){__uint_as_float(bw.z << 16), __uint_as_float(bw.z & 0xffff0000u), __uint_as_float(bw.w << 16), __uint_as_float(bw.w & 0xffff0000u)}; }
                float* o = outF + (size_t)row * DM + c0;
#pragma unroll
                for (int e = 0; e < 4; ++e) { atomicAdd(o + e, y0[e]); atomicAdd(o + 4 + e, y1[e]); } }
    }
};
struct CmpOrder {
    int G, c;
    __device__ __forceinline__ bool next(int i, Unit& u) const { const int L = i * G + c; if (L >= 2 * (CMP_ROWS / 256)) return false; u.pm = L; u.pn = L >= CMP_ROWS / 256 ? 1 : 0; u.kc = 0; return true; }
    __device__ __forceinline__ void a_ready(const Unit&) const {}
    __device__ __forceinline__ void done(const Unit&) const {}
};
struct EpiCmp1Both {
    static constexpr bool PERM = true, AFTER_DRAIN = false;
    const float* b1; const float* b1eff; float* H1;
    __device__ __forceinline__ void operator()(const f32x4 (&acc)[2][2][4][2], const Unit& u, int wr, int wc, int fr, int fq) const {
        const int which = u.pm >= (CMP_ROWS / 256) ? 1 : 0; Unit u2 = u; u2.pm = u.pm - which * (CMP_ROWS / 256);
        EpiCmp1 e{which, b1, b1eff, H1}; e(acc, u2, wr, wc, fr, fq);
    }
};


#ifndef PHMASK
#define PHMASK 0x7fff
#endif
#define IN(k) (((PHMASK >> ((k) >= 11 ? (k) - 6 : (k))) & 1) && lo <= (k) && (k) < hi)
#define SEAM(k) do { if (IN(k) && IN((k) + 1)) xcd_barrier(bar); } while (0)
#ifndef PROBE_REP
#define PROBE_REP -1
#endif
#define PROBE_N(k) (PROBE_REP == (k) ? 2 : 1)
template <int layer>
__device__ __forceinline__ void layer_tail(Frame& F, const XcdBarrier& bar, int lo, int hi) {
    unsigned char* ws = F.ws; float* ssqA = (float*)(ws + WS_CTL) + CW_SSQ; bf16* MIX = (bf16*)(ws + WS_MIX);
    constexpr int pb = layer ? 11 : 5;
    bf16* YmidB = (bf16*)(ws + (layer ? WS_Y3B : WS_Y1B)); float* ssqMid = ssqA + (layer ? 2 : 0) * SSQ_STRIDE;
    if (IN(pb)) {
        const bf16* base = layer ? (const bf16*)(ws + WS_Y2B) : (const bf16*)(ws + WS_XB);
        sg::resid<true>(F, MIX, (const bf16*)(ws + WS_WOUT) + (size_t)layer * DM * DM, DM, nullptr, base, nullptr, YmidB, ssqMid); __syncthreads();
#pragma unroll 1
        for (int rep_ = 0; rep_ < (layer == 0 ? PROBE_N(5) : 1); ++rep_) {
            { pg8::Gemm g{MIX, (const bf16*)(ws + WS_WOUT) + (size_t)layer * DM * DM, MP, DM, DM, 0}; pg8::StaticOrder S; S.init(MP, DM, F.G, (int)blockIdx.x);
              EpiResidT<false> E{base, nullptr, rep_ ? (bf16*)nullptr : YmidB, rep_ ? (float*)nullptr : ssqMid};
              pg8::gemm_phase<EpiResidT<false>, pg8::StaticOrder, true, true>(F.lds + RING_OFF, g, S, E); }
            if (rep_ + 1 < (layer == 0 ? PROBE_N(5) : 1)) __syncthreads(); }
        SEAM(pb);
    }
    if (IN(pb + 1)) {
        sg::up(F, YmidB, (const bf16*)(ws + WS_WUP) + (size_t)layer * NUP * DM, ssqMid); __syncthreads();
        pg8::Gemm g{YmidB, (const bf16*)(ws + WS_WUP) + (size_t)layer * NUP * DM, MP, NUP, DM, 0}; pg8::StaticOrder S; S.init(MP, NUP, F.G, (int)blockIdx.x);
        EpiUpConv E{ssqMid, (bf16*)(ws + WS_ACT), (float*)(ws + WS_UB), (float*)(ws + WS_US), F.out + O_CONVP + (size_t)layer * NB * 2 * NUP,
                    FIN(F, I_CONVW) + (size_t)layer * 3 * NUP, FIN(F, I_CONVB) + (size_t)layer * NUP, F.lds};
#pragma unroll 1
        for (int rep_ = 0; rep_ < (layer == 0 ? PROBE_N(6) : 1); ++rep_) {
            pg8::gemm_phase<EpiUpConv, pg8::StaticOrder, true, true>(F.lds + RING_OFF, g, S, E); if (rep_ + 1 < (layer == 0 ? PROBE_N(6) : 1)) __syncthreads(); }
        SEAM(pb + 1);
    }
    if (IN(pb + 2)) { p7_fixup(F, layer); SEAM(pb + 2); }
    if (IN(pb + 3)) {
#pragma unroll 1
        for (int rep_ = 0; rep_ < (layer == 0 ? PROBE_N(8) : 1); ++rep_) {
            float* oF = layer ? F.out + O_YP : (float*)nullptr; bf16* oB = (layer || rep_) ? (bf16*)nullptr : (bf16*)(ws + WS_Y2B); float* sq = (layer || rep_) ? (float*)nullptr : ssqA + SSQ_STRIDE;
            if (rep_ == 0) { sg::resid<true>(F, (const bf16*)(ws + WS_ACT), (const bf16*)(ws + WS_WDOWN) + (size_t)layer * DM * DFF, DFF, nullptr, YmidB, oF, oB, sq); __syncthreads(); }
            { pg8::Gemm g{(const bf16*)(ws + WS_ACT), (const bf16*)(ws + WS_WDOWN) + (size_t)layer * DM * DFF, MP, DM, DFF, 0}; pg8::StaticOrder S; S.init(MP, DM, F.G, (int)blockIdx.x);
              EpiResidT<false> E{YmidB, oF, oB, sq};
              pg8::gemm_phase<EpiResidT<false>, pg8::StaticOrder, true, true>(F.lds + RING_OFF, g, S, E); }
            if (rep_ + 1 < (layer == 0 ? PROBE_N(8) : 1)) __syncthreads(); }
        if (layer == 0) SEAM(pb + 3);
    }
}

__global__ void __launch_bounds__(NWAVES * 64, 2) mk_fwd(Args args) {
    extern __shared__ __attribute__((aligned(16))) unsigned char lds[];
    Frame F;
    F.lds = (LAS unsigned char*)lds; F.tid = threadIdx.x; F.lane = F.tid & 63; F.wave = __builtin_amdgcn_readfirstlane(F.tid >> 6);
    F.G = gridDim.x; F.gw = blockIdx.x * NWAVES + F.wave; F.NGW = F.G * NWAVES;
    F.in = args.in; F.out = args.out; F.ws = args.ws;
    unsigned char* ws = args.ws;
    unsigned* ctl = (unsigned*)(ws + WS_CTL);
    volatile LAS unsigned* MISC = (volatile LAS unsigned*)(F.lds + MISC_OFF);
    for (int u = F.tid; u < (LDS_BYTES - LDSCTL_OFF) / 4; u += NWAVES * 64) ((LAS unsigned*)(F.lds + LDSCTL_OFF))[u] = 0u;
    __syncthreads();
    XcdBarrier bar; bar.bar = ctl + CW_BAR; bar.x = 0; bar.st = nullptr;
    if (N_LAUNCHES == 1) bar = xcd_barrier_post(ctl + CW_BAR, MISC + 8);
    const int lo = args.ph_lo, hi = args.ph_hi;
    float* ssqA = (float*)ctl + CW_SSQ;
    bf16* XB = (bf16*)(ws + WS_XB); bf16* MIX = (bf16*)(ws + WS_MIX);

#ifndef PROBE_REP
#define PROBE_REP -1
#endif
    if (IN(0)) { p0_prologue(F, true); if (PROBE_REP == 0) { __syncthreads(); p0_prologue(F, false); } SEAM(0); }

    if (IN(1)) {
#pragma unroll 1
      for (int rep_ = 0; rep_ < PROBE_N(1); ++rep_) {
        { pg8::Gemm g{XB, (const bf16*)(ws + WS_WIN0), MP, NIN0, DM, 0}; pg8::StaticOrder S; S.init(MP, NIN0, F.G, (int)blockIdx.x);
          EpiInNsa E{(const float*)(ws + WS_SSQ0), FIN(F, I_QG), FIN(F, I_KG), FIN(F, I_XQG), (float*)(ws + WS_Q), (float*)(ws + WS_XQ), (float*)(ws + WS_G), F.out, (bf16*)(ws + WS_QB), (bf16*)(ws + WS_XQB), (bf16*)(ws + WS_KSB), (bf16*)(ws + WS_VST), (bf16*)(ws + WS_KWB), (bf16*)(ws + WS_VWT), F.lds};
          pg8::gemm_phase<EpiInNsa, pg8::StaticOrder, true, true>(F.lds + RING_OFF, g, S, E); }
        if (rep_ + 1 < PROBE_N(1)) __syncthreads(); }
        SEAM(1);
    }
    if (IN(2)) {
        float* H1 = (float*)(ws + WS_H1);
#pragma unroll 1
        for (int t = blockIdx.x; t < 256; t += F.G) { cf::cmp_tile<true, 8>(F, t >> 3, (t >> 2) & 1, (t & 3) * 64, H1); __syncthreads(); }
        const bool split = F.G >= 128; const int bx = (int)blockIdx.x;
        if (!split || (bx >= 64 && bx < 128)) {
#pragma unroll 1
            for (int t = split ? bx - 64 : bx; t < 64; t += F.G) { cf::cmp_tile_p32(F, t >> 3, (t >> 2) & 1, (t & 3) * 16, H1); __syncthreads(); } }
        if (!split || (bx >= 16 && bx < 48)) {
            pg8::Gemm g{(const bf16*)(ws + WS_MEMN), (const bf16*)(ws + WS_WMEM), NB * NMEM, 1024, DM, 0}; pg8::StaticOrder S; S.init(NB * NMEM, 1024, split ? 32 : F.G, split ? bx - 16 : bx);
            EpiMemKV E{FIN(F, I_XKG), F.out, (bf16*)(ws + WS_MKB), (bf16*)(ws + WS_MVT)};
            pg8::gemm_phase<EpiMemKV, pg8::StaticOrder, true, true>(F.lds + RING_OFF, g, S, E);
        }
        if (!split) __syncthreads();
        if (!split || (bx >= 48 && bx < 56)) {
            pg8::Gemm g{XB, (const bf16*)(ws + WS_WIN0), MT, NIN0, DM, 0}; PanelOrder S{MP / 256, NIN0 / 256, split ? 8 : F.G, split ? bx - 48 : bx};
            EpiInNsa E{(const float*)(ws + WS_SSQ0), FIN(F, I_QG), FIN(F, I_KG), FIN(F, I_XQG), (float*)(ws + WS_Q), (float*)(ws + WS_XQ), (float*)(ws + WS_G), F.out, (bf16*)(ws + WS_QB), (bf16*)(ws + WS_XQB), (bf16*)(ws + WS_KSB), (bf16*)(ws + WS_VST), (bf16*)(ws + WS_KWB), (bf16*)(ws + WS_VWT), F.lds};
            pg8::gemm_phase<EpiInNsa, PanelOrder, true, true>(F.lds + RING_OFF, g, S, E);
        }
        SEAM(2);
    }
    if (IN(3)) { p3_compress2(F); if (PROBE_REP == 3) { __syncthreads(); p3_compress2(F); } SEAM(3); }
    if (IN(4)) { p4_attention0(F); SEAM(4); }

    layer_tail<0>(F, bar, lo, hi);
            if (IN(9)) {
                sg::in1(F, ssqA + SSQ_STRIDE); __syncthreads();
                pg8::Gemm g{(const bf16*)(ws + WS_Y2B), (const bf16*)(ws + WS_WIN1), MP, DM, DM, 0}; pg8::StaticOrder S; S.init(MP, DM, F.G, (int)blockIdx.x);
                EpiInPool E{ssqA + SSQ_STRIDE, FIN(F, I_XQG) + 64, (float*)(ws + WS_UP), (float*)(ws + WS_XQ), F.out, (bf16*)(ws + WS_XQB)};
                pg8::gemm_phase<EpiInPool, pg8::StaticOrder, true, true>(F.lds + RING_OFF, g, S, E);
                SEAM(9);
            }
            if (IN(10)) { p10_pool_attn(F); if (PROBE_REP == 10) { __syncthreads(); p10_pool_attn(F); } SEAM(10); }
    layer_tail<1>(F, bar, lo, hi);
#undef IN
#undef SEAM
}

extern "C" void kernel_launch(void* const* d_in, const int* in_sizes, int n_in, void* d_out, int out_size, void* d_ws, size_t ws_size, hipStream_t stream) {
    static int grid = 0;
    if (grid == 0) {
        if (n_in != N_IN || (size_t)out_size != O_END || ws_size < WS_END) { fprintf(stderr, "kernel_launch: unexpected problem (n_in %d, out %d, ws %zu)\n", n_in, out_size, ws_size); grid = -1; return; }
        int dev = 0, cus = 0, per_cu = 0;
        if (hipGetDevice(&dev) != hipSuccess || hipDeviceGetAttribute(&cus, hipDeviceAttributeMultiprocessorCount, dev) != hipSuccess) { grid = -1; return; }
        if (hipFuncSetAttribute((const void*)mk_fwd, hipFuncAttributeMaxDynamicSharedMemorySize, LDS_BYTES) != hipSuccess) { fprintf(stderr, "kernel_launch: hipFuncSetAttribute failed\n"); grid = -1; return; }
        if (hipOccupancyMaxActiveBlocksPerMultiprocessor(&per_cu, (const void*)mk_fwd, NWAVES * 64, LDS_BYTES) != hipSuccess || per_cu < 1) { fprintf(stderr, "kernel_launch: occupancy query says %d\n", per_cu); }
        (void)hipGetLastError();
        grid = cus;
    }
    if (grid < 0) return;
    if (hipMemsetAsync((char*)d_ws + WS_CTL, 0, CTL_ZERO_BYTES, stream) != hipSuccess) return;
    Args a{};
    for (int i = 0; i < N_IN; ++i) a.in[i] = d_in[i];
    a.out = (float*)d_out; a.ws = (unsigned char*)d_ws;
    if (N_LAUNCHES == 1) { a.ph_lo = 0; a.ph_hi = NPH; hipLaunchKernelGGL(mk_fwd, dim3(grid), dim3(NWAVES * 64), LDS_BYTES, stream, a); }
    else for (int p = 0; p < NPH; ++p) { a.ph_lo = p; a.ph_hi = p + 1; hipLaunchKernelGGL(mk_fwd, dim3(grid), dim3(NWAVES * 64), LDS_BYTES, stream, a); }
}
```

```cpp
#include <hip/hip_runtime.h>
#include <cstdio>
#include <cstdint>
#define MK_N_LAUNCHES 1
namespace pg8 {
#define PG8_LAS __attribute__((address_space(3)))
typedef unsigned short bf16_t;
typedef short bf16x8 __attribute__((ext_vector_type(8)));
typedef float f32x4 __attribute__((ext_vector_type(4)));
typedef unsigned u32x4 __attribute__((ext_vector_type(4)));
constexpr int BM = 256, BK = 64, HALF = 128, HTB = HALF * BK * 2  , STAGE_BYTES = 8 * HTB, NXCD = 8, WGM = 8;

__host__ __device__ __forceinline__ int lds_byte(int r, int c) { const int st = (r >> 4) * 2 + (c >> 5), rr = r & 15, cc = c & 31, ob = rr * 64 + cc * 2; return st * 1024 + (ob ^ (((ob >> 9) & 1) << 5)); }
__host__ __device__ __forceinline__ void stage_rc(int b, int& R, int& C) { const int st = b / 1024, sb = b % 1024, swz = sb ^ (((sb >> 9) & 1) << 5); R = (st >> 1) * 16 + swz / 64; C = (st & 1) * 32 + (swz % 64) / 2; }
__host__ __device__ __forceinline__ int perm32(int rho) { const int n = rho >> 4, i = rho & 15; return 8 * (i >> 2) + 4 * n + (i & 3); }

struct Unit { int pm, pn, kc; };
struct Gemm { const bf16_t* A; const bf16_t* Bt; int M, N, K; int Kloop; };

struct StaticOrder {
    int nM, nN, nwg, G, c;
    __host__ __device__ void init(int M, int N, int G_, int c_) { nM = M / BM; nN = N / BM; nwg = nM * nN; G = G_; c = c_; }
    __host__ __device__ bool next(int i, Unit& u) const {
        const long L = (long)i * G + c; if (L >= nwg) return false;
        int wgid = (int)L; { const int q = nwg / NXCD, r = nwg % NXCD, xcd = wgid % NXCD, off = wgid / NXCD; wgid = (xcd < r ? xcd * (q + 1) : r * (q + 1) + (xcd - r) * q) + off; }
        const int nig = WGM * nN, gid = wgid / nig, fm = gid * WGM, gsz = (nM - fm) < WGM ? (nM - fm) : WGM;
        u.pm = fm + ((wgid % nig) % gsz); u.pn = (wgid % nig) / gsz; u.kc = 0; return true;
    }
    __device__ __forceinline__ void a_ready(const Unit&) const {}
    __device__ __forceinline__ void done(const Unit&) const {}
};


__device__ __forceinline__ unsigned cvt_pk_bf16(float lo, float hi) { unsigned r; asm volatile("v_cvt_pk_bf16_f32 %0, %1, %2" : "=v"(r) : "v"(lo), "v"(hi)); return r; }
typedef float f32x2 __attribute__((ext_vector_type(2)));
template <class Epi, class Sched, bool ALIGN_EPI = false, bool SP2 = false, bool HALFN = false, bool BHALF = false, bool KSPLIT = false>
__device__ __forceinline__ void gemm_phase(PG8_LAS unsigned char* lds, const Gemm g, const Sched& S, const Epi& E) {
    const int tid = threadIdx.x, wid = __builtin_amdgcn_readfirstlane(tid >> 6), lane = tid & 63, wr = wid >> 2, wc = wid & 3, fr = lane & 15, fq = lane >> 4;
    const int K = g.K, nt = (KSPLIT ? g.Kloop : K) / BK;
    unsigned voffA[2], voffB[2];
#pragma unroll
    for (int i = 0; i < 2; ++i) { int R, C; stage_rc(tid * 16 + i * 8192, R, C); const int Rb = Epi::PERM ? ((R & ~31) + perm32(R & 31)) : R;
        voffA[i] = (unsigned)(R * K + C) * 2u; voffB[i] = (unsigned)(Rb * K + C) * 2u; }
    const size_t kstep = (size_t)(BK * 2);
    const size_t hstep = (size_t)HALF * K * 2;
    const size_t tstep = 2 * hstep;
    const unsigned ldsw = (unsigned)wid * 1024u;
    const int aoff = lds_byte(wr * 64 + fr, fq * 8), boff = lds_byte(wc * 32 + fr, fq * 8);
#define PG8_SA(b, h) (((b) * 2 + (h)) * HTB)
#define PG8_SB(b, h) ((4 + (b) * 2 + (h)) * HTB)
#define PG8_STAGE(bufoff, gbase, voff) do { _Pragma("unroll") for (int _i = 0; _i < 2; ++_i) \
        __builtin_amdgcn_global_load_lds((const unsigned*)((const char*)(gbase) + (voff)[_i]), (PG8_LAS unsigned*)(lds + (bufoff) + ldsw + _i * 8192), 16, 0, 0); } while (0)
#define PG8_LDA(dst, b, h) do { _Pragma("unroll") for (int m = 0; m < 4; ++m) _Pragma("unroll") for (int k = 0; k < 2; ++k) dst[m][k] = *(const PG8_LAS bf16x8*)(lds + PG8_SA(b, h) + aoff + m * 2048 + k * 1024); } while (0)
#define PG8_LDB(dst, b, h) do { _Pragma("unroll") for (int n = 0; n < 2; ++n) _Pragma("unroll") for (int k = 0; k < 2; ++k) dst[n][k] = *(const PG8_LAS bf16x8*)(lds + PG8_SB(b, h) + boff + n * 2048 + k * 1024); } while (0)
#define PG8_MMA(ai, bj, At, Bt) do { __builtin_amdgcn_s_setprio(1); _Pragma("unroll") for (int m = 0; m < 4; ++m) _Pragma("unroll") for (int n = 0; n < 2; ++n) _Pragma("unroll") for (int k = 0; k < 2; ++k) \
        acc[ai][bj][m][n] = __builtin_amdgcn_mfma_f32_16x16x32_bf16(Bt[n][k], At[m][k], acc[ai][bj][m][n], 0, 0, 0); __builtin_amdgcn_s_setprio(0); } while (0)
#define PG8_WAIT_V(n) asm volatile("s_waitcnt vmcnt(" #n ")" ::: "memory")
#define PG8_WAIT_L(n) asm volatile("s_waitcnt lgkmcnt(" #n ")" ::: "memory")
#define PG8_BAR __builtin_amdgcn_s_barrier()
#define PG8_SCHED __builtin_amdgcn_sched_barrier(0)
    Unit cur, nxt; int ui = 0;
    if (!S.next(0, cur)) return;
    f32x4 acc[2][2][4][2];
#pragma unroll
    for (int a = 0; a < 2; ++a)
#pragma unroll
        for (int b = 0; b < 2; ++b)
#pragma unroll
            for (int m = 0; m < 4; ++m)
#pragma unroll
                for (int n = 0; n < 2; ++n) acc[a][b][m][n] = (f32x4){0.f, 0.f, 0.f, 0.f};
    bf16x8 At[4][2], B0[2][2], B1[2][2];
    const char* cA = (const char*)g.A + (size_t)cur.pm * tstep + (KSPLIT ? (size_t)cur.kc * g.Kloop * 2 : 0); const char* cB = (const char*)g.Bt + (size_t)cur.pn * (BHALF ? hstep : tstep) + (KSPLIT ? (size_t)cur.kc * g.Kloop * 2 : 0);
    S.a_ready(cur);
    if constexpr (SP2) {
        PG8_STAGE(PG8_SB(0, 0), cB, voffB); PG8_STAGE(PG8_SB(0, 1), cB + hstep, voffB); PG8_STAGE(PG8_SA(0, 0), cA, voffA); PG8_STAGE(PG8_SA(0, 1), cA + hstep, voffA);
        if (wr == 1) PG8_BAR;
        PG8_WAIT_V(2); PG8_BAR;
        PG8_STAGE(PG8_SB(1, 0), cB + kstep, voffB); PG8_STAGE(PG8_SA(1, 0), cA + kstep, voffA); PG8_STAGE(PG8_SB(1, 1), cB + hstep + kstep, voffB);
        PG8_WAIT_V(6); PG8_BAR;
    } else {
        PG8_STAGE(PG8_SB(0, 0), cB, voffB); PG8_STAGE(PG8_SA(0, 0), cA, voffA); PG8_STAGE(PG8_SB(0, 1), cB + hstep, voffB); PG8_STAGE(PG8_SA(0, 1), cA + hstep, voffA);
        if (wr == 1) PG8_BAR;
        PG8_WAIT_V(4); PG8_BAR;
        PG8_STAGE(PG8_SB(1, 0), cB + kstep, voffB); PG8_STAGE(PG8_SA(1, 0), cA + kstep, voffA); PG8_STAGE(PG8_SB(1, 1), cB + hstep + kstep, voffB);
        PG8_WAIT_V(6); PG8_BAR;
    }
    for (;;) {
        const bool has_next = S.next(ui + 1, nxt);
        const char* nA = has_next ? (const char*)g.A + (size_t)nxt.pm * tstep + (KSPLIT ? (size_t)nxt.kc * g.Kloop * 2 : 0) : cA; const char* nB = has_next ? (const char*)g.Bt + (size_t)nxt.pn * (BHALF ? hstep : tstep) + (KSPLIT ? (size_t)nxt.kc * g.Kloop * 2 : 0) : cB;
        for (int t = 0; t < nt; t += 2) {
            const bool last = (t == nt - 2);
            const char* a1 = cA + (size_t)(t + 1) * kstep;
            const char* a2 = last ? nA : cA + (size_t)(t + 2) * kstep; const char* b2 = last ? nB : cB + (size_t)(t + 2) * kstep;
            const char* a3 = a2 + kstep; const char* b3 = b2 + kstep;
            if (last && has_next) S.a_ready(nxt);
            if constexpr (SP2) {
            PG8_LDB(B0, 0, 0); PG8_LDB(B1, 0, 1); PG8_SCHED; PG8_LDA(At, 0, 0); PG8_STAGE(PG8_SA(1, 1), a1 + hstep, voffA);
            PG8_WAIT_V(8); PG8_WAIT_L(0); PG8_BAR; PG8_MMA(0, 0, At, B0); if constexpr (!HALFN) { PG8_MMA(0, 1, At, B1); } PG8_BAR; PG8_SCHED;
            PG8_LDA(At, 0, 1); PG8_STAGE(PG8_SB(0, 0), b2, voffB); PG8_STAGE(PG8_SB(0, 1), b2 + hstep, voffB); PG8_STAGE(PG8_SA(0, 0), a2, voffA);
            PG8_WAIT_V(8); PG8_WAIT_L(0); PG8_BAR; PG8_MMA(1, 0, At, B0); if constexpr (!HALFN) { PG8_MMA(1, 1, At, B1); } PG8_BAR; PG8_SCHED;
            PG8_LDB(B0, 1, 0); PG8_LDB(B1, 1, 1); PG8_SCHED; PG8_LDA(At, 1, 0); PG8_STAGE(PG8_SA(0, 1), a2 + hstep, voffA);
            PG8_WAIT_V(8); PG8_WAIT_L(0); PG8_BAR; PG8_MMA(0, 0, At, B0); if constexpr (!HALFN) { PG8_MMA(0, 1, At, B1); } PG8_BAR; PG8_SCHED;
            PG8_LDA(At, 1, 1); PG8_STAGE(PG8_SB(1, 0), b3, voffB); PG8_STAGE(PG8_SB(1, 1), b3 + hstep, voffB); PG8_STAGE(PG8_SA(1, 0), a3, voffA);
            PG8_WAIT_V(8); PG8_WAIT_L(0); PG8_BAR; PG8_MMA(1, 0, At, B0); if constexpr (!HALFN) { PG8_MMA(1, 1, At, B1); } PG8_BAR; PG8_SCHED;
            } else {
            PG8_LDB(B0, 0, 0); PG8_SCHED; PG8_LDA(At, 0, 0); PG8_STAGE(PG8_SA(1, 1), a1 + hstep, voffA);
            PG8_WAIT_L(8); PG8_BAR; PG8_WAIT_L(0); PG8_MMA(0, 0, At, B0); PG8_BAR; PG8_SCHED;
            PG8_LDB(B1, 0, 1); PG8_STAGE(PG8_SB(0, 0), b2, voffB);
            PG8_BAR; PG8_WAIT_L(0); PG8_MMA(0, 1, At, B1); PG8_BAR;
            PG8_LDA(At, 0, 1); PG8_STAGE(PG8_SA(0, 0), a2, voffA);
            PG8_BAR; PG8_WAIT_L(0); PG8_MMA(1, 0, At, B0); PG8_BAR; PG8_SCHED;
            PG8_STAGE(PG8_SB(0, 1), b2 + hstep, voffB);
            PG8_WAIT_V(6); PG8_BAR; PG8_MMA(1, 1, At, B1); PG8_BAR;
            PG8_LDB(B0, 1, 0); PG8_SCHED; PG8_LDA(At, 1, 0); PG8_STAGE(PG8_SA(0, 1), a2 + hstep, voffA);
            PG8_WAIT_L(8); PG8_BAR; PG8_WAIT_L(0); PG8_MMA(0, 0, At, B0); PG8_BAR; PG8_SCHED;
            PG8_LDB(B1, 1, 1); PG8_STAGE(PG8_SB(1, 0), b3, voffB);
            PG8_BAR; PG8_WAIT_L(0); PG8_MMA(0, 1, At, B1); PG8_BAR;
            PG8_LDA(At, 1, 1); PG8_STAGE(PG8_SA(1, 0), a3, voffA);
            PG8_BAR; PG8_WAIT_L(0); PG8_MMA(1, 0, At, B0); PG8_BAR; PG8_SCHED;
            PG8_STAGE(PG8_SB(1, 1), b3 + hstep, voffB);
            PG8_WAIT_V(6); PG8_BAR; PG8_MMA(1, 1, At, B1); PG8_BAR;
            }
        }
        if constexpr (ALIGN_EPI) { if (wr == 0) PG8_BAR; }
        if constexpr (!Epi::AFTER_DRAIN) { E(acc, cur, wr, wc, fr, fq); S.done(cur); }
        if (!has_next) break;
#pragma unroll
        for (int a = 0; a < 2; ++a)
#pragma unroll
            for (int b = 0; b < 2; ++b)
#pragma unroll
                for (int m = 0; m < 4; ++m)
#pragma unroll
                    for (int n = 0; n < 2; ++n) acc[a][b][m][n] = (f32x4){0.f, 0.f, 0.f, 0.f};
        cur = nxt; cA = nA; cB = nB; ++ui;
        if constexpr (ALIGN_EPI) { if (wr == 1) PG8_BAR; }
    }
    PG8_WAIT_V(0);
    if constexpr (!ALIGN_EPI) { if (wr == 0) PG8_BAR; }
    PG8_BAR;
    if constexpr (Epi::AFTER_DRAIN) { E.fused(acc, cur, wr, wc, fr, fq, lds, wid, lane); S.done(cur); }
#undef PG8_SA
#undef PG8_SB
#undef PG8_STAGE
#undef PG8_LDA
#undef PG8_LDB
#undef PG8_MMA
#undef PG8_WAIT_V
#undef PG8_WAIT_L
#undef PG8_BAR
#undef PG8_SCHED
}
}
#define LAS __attribute__((address_space(3)))
#define XB_TMO      128
#define XB_XCNT(j)  (256  + 64 * (j))
#define XB_XSUB(j)  (1280 + 64 * (j))
#define XB_XGEN(j)  (2304 + 64 * (j))
#define XB_TOP      3328
#define XB_TOPGEN   3392
#define XCD_BAR_WORDS 3456
#define XB_SPIN_CAP (1u << 18)

__device__ __forceinline__ unsigned xb_ld(unsigned* p)              { return __hip_atomic_load(p, __ATOMIC_RELAXED, __HIP_MEMORY_SCOPE_AGENT); }
__device__ __forceinline__ unsigned xb_add(unsigned* p, unsigned v) { return __hip_atomic_fetch_add(p, v, __ATOMIC_RELAXED, __HIP_MEMORY_SCOPE_AGENT); }
__device__ __forceinline__ unsigned xb_xcc_id() { return (unsigned)__builtin_amdgcn_s_getreg((3 << 11) | 20) & 0xFu; }
#define XB_SPIN(cond, bar) do { unsigned _sp = 0; while (cond) { __builtin_amdgcn_s_sleep(1); \
    if ((++_sp & 255u) == 0u) { if (xb_ld(&(bar)[XB_TMO])) break; if (_sp > XB_SPIN_CAP) { atomicAdd(&(bar)[XB_TMO], 1u); break; } } } } while (0)

struct XcdBarrier {
    unsigned* bar; unsigned x;
    volatile LAS unsigned* st;
};

__device__ __forceinline__ XcdBarrier xcd_barrier_post(unsigned* bar, volatile LAS unsigned* st) {
    XcdBarrier b; b.bar = bar; b.x = xb_xcc_id(); b.st = st;
    if (threadIdx.x == 0) (void)xb_add(&bar[XB_XCNT(b.x)], 1u);
    return b;
}
__device__ __forceinline__ void xcd_barrier_complete(unsigned* bar, unsigned x, unsigned& nloc, unsigned& nx) {
    const unsigned G = gridDim.x * gridDim.y * gridDim.z;
    unsigned sum, cnt, mine, sp = 0u;
    for (;;) {
        sum = 0u; cnt = 0u; mine = 0u;
#pragma unroll
        for (unsigned j = 0; j < 16; ++j) { const unsigned c = xb_ld(&bar[XB_XCNT(j)]); sum += c; cnt += (c > 0u) ? 1u : 0u; mine = (j == x) ? c : mine; }
        if (sum == G) break;
        __builtin_amdgcn_s_sleep(1);
        if ((++sp & 255u) == 0u) { if (xb_ld(&bar[XB_TMO])) break; if (sp > XB_SPIN_CAP) { atomicAdd(&bar[XB_TMO], 1u); break; } }
    }
    nloc = mine > 0u ? mine : 1u; nx = cnt > 0u ? cnt : 1u;
}

__device__ __forceinline__ void xcd_barrier(const XcdBarrier& b) {
    asm volatile("s_waitcnt vmcnt(0)" ::: "memory");
    __syncthreads();
    if (threadIdx.x == 0) {
        unsigned* bar = b.bar;
        __builtin_amdgcn_s_waitcnt(0);
        unsigned nloc = b.st[0], nx = b.st[1];
        if (nloc == 0u) { xcd_barrier_complete(bar, b.x, nloc, nx); b.st[0] = nloc; b.st[1] = nx; }
        const unsigned old = xb_add(&bar[XB_XSUB(b.x)], 1u);
        const unsigned gen = old / nloc;
        if (old + 1u == (gen + 1u) * nloc) {
            __builtin_amdgcn_fence(__ATOMIC_RELEASE, "agent");
            asm volatile("s_waitcnt vmcnt(0)" ::: "memory");
            const unsigned og = xb_add(&bar[XB_TOP], 1u);
            const unsigned tg = og / nx;
            if (og + 1u == (tg + 1u) * nx) xb_add(&bar[XB_TOPGEN], 1u);
            else XB_SPIN(xb_ld(&bar[XB_TOPGEN]) == tg, bar);
            __builtin_amdgcn_fence(__ATOMIC_ACQUIRE, "agent");
            xb_add(&bar[XB_XGEN(b.x)], 1u);
            asm volatile("s_waitcnt vmcnt(0)" ::: "memory");
        } else {
            XB_SPIN(xb_ld(&bar[XB_XGEN(b.x)]) == gen, bar);
            __builtin_amdgcn_fence(__ATOMIC_ACQUIRE, "agent");
            asm volatile("s_waitcnt vmcnt(0)" ::: "memory");
        }
    }
    __syncthreads();
}
#undef LAS

constexpr int DM = 1024, NB = 8, SEQ = 4096, DBATCH = 32, DSEQ = 8, PAST = 16384, PAGE = 128, NPAGES = PAST / PAGE;
constexpr int MP = NB * SEQ, MS = DBATCH * DSEQ, MT = MP + MS;
constexpr int NIN0 = 2048;
constexpr int NSA_IN = 1828, DFF = 2816, NUP = 2 * DFF, NMEM = 256;
constexpr int CMP_ROWS_P = NB * 64 * 2, CMP_ROWS_S = DBATCH * 256 * 2, CMP_ROWS = CMP_ROWS_P + CMP_ROWS_S;
constexpr float EPS = 1e-6f, QSCALE_ = 0.125f * 1.4426950408889634f;
constexpr size_t O_YP = 0, O_YS = O_YP + (size_t)MP * DM, O_KVP = O_YS + (size_t)MS * DM, O_KVS = O_KVP + (size_t)MP * 512, O_WINP = O_KVS + (size_t)MS * 512,
                 O_WINS = O_WINP + (size_t)NB * 512 * 256, O_MKV = O_WINS + (size_t)DBATCH * 512 * 256, O_POOLP = O_MKV + (size_t)2 * NB * NMEM * 512,
                 O_POOLS = O_POOLP + (size_t)NB * 15 * 768, O_CONVP = O_POOLS + (size_t)DBATCH * 15 * 768, O_CONVS = O_CONVP + (size_t)2 * NB * 2 * NUP,
                 O_END = O_CONVS + (size_t)2 * DBATCH * 2 * NUP;
static_assert(O_END == 59426816, "output size");
enum { I_XP = 0, I_XS, I_CKV, I_CWIN, I_CMEM, I_SPOOL, I_SCONV, I_PT, I_MEMP, I_RELB, I_GMIX, I_GMEM, I_GFFN, I_WINNSA, I_QG, I_KG, I_CPOS, I_CW1, I_CB1, I_CW2, I_CB2,
       I_WINPOOL, I_WPG, I_PSCALE, I_WMEMKV, I_XQG, I_XKG, I_WOUT, I_WUP, I_CONVW, I_CONVB, I_WDOWN, N_IN };
constexpr size_t MiB = 1u << 20;
constexpr size_t WS_CTL = 0, CTL_ZERO_BYTES = 1 * MiB;
constexpr size_t WS_WIN0 = 4 * MiB, WS_WIN1 = 8 * MiB, WS_WMEM = 10 * MiB, WS_WOUT = 12 * MiB, WS_WUP = 16 * MiB, WS_WDOWN = 38 * MiB, WS_WC1 = 49 * MiB, WS_SSQ0 = 51 * MiB,
                 WS_MEMN = 52 * MiB, WS_KC = 56 * MiB, WS_H1 = 66 * MiB, WS_XB = 84 * MiB, WS_Q = 150 * MiB, WS_XQ = 248 * MiB, WS_G = 282 * MiB, WS_WINP = 292 * MiB,
                 WS_CMPA = 324 * MiB, WS_MIX = 596 * MiB, WS_Y1 = 662 * MiB, WS_Y1B = 792 * MiB, WS_U = 858 * MiB, WS_ACT = 1214 * MiB, WS_Y2 = 1392 * MiB, WS_Y2B = 1522 * MiB,
                 WS_UP = 1588 * MiB, WS_Y3 = 1686 * MiB, WS_Y3B = 1816 * MiB, WS_QB = 1882 * MiB, WS_XQB = 1930 * MiB, WS_KSB = 1946 * MiB, WS_VST = 1954 * MiB,
                 WS_KWB = 1962 * MiB, WS_VWT = 1970 * MiB, WS_KCB = 1978 * MiB, WS_VCT = 1979 * MiB, WS_MKB = 1980 * MiB, WS_MVT = 1982 * MiB, WS_UB = 1984 * MiB, WS_US = 1996 * MiB, WS_WC1B = 2002 * MiB, WS_H1N = 2006 * MiB, WS_END = 2024 * MiB;
static_assert(WS_WUP + (size_t)2 * NUP * DM * 2 <= WS_WDOWN && WS_WDOWN + (size_t)2 * DM * DFF * 2 <= WS_WC1 && WS_KC + (size_t)2 * CMP_ROWS * 64 * 4 <= WS_H1 &&
              WS_H1 + (size_t)2 * CMP_ROWS * 128 * 4 <= WS_XB && WS_XB + (size_t)MT * DM * 2 <= WS_Q && WS_Q + (size_t)MT * 768 * 4 <= WS_XQ && WS_XQ + (size_t)MT * 256 * 4 <= WS_G &&
              WS_G + (size_t)MT * 64 * 4 <= WS_WINP && WS_WINP + (size_t)MP * 256 * 4 <= WS_CMPA && WS_CMPA + (size_t)2 * CMP_ROWS * 4096 * 2 <= WS_MIX &&
              WS_MIX + (size_t)MT * DM * 2 <= WS_Y1 && WS_Y1 + (size_t)MT * DM * 4 <= WS_Y1B && WS_Y1B + (size_t)MT * DM * 2 <= WS_U && WS_U + (size_t)MT * NUP * 2 <= WS_ACT &&
              WS_ACT + (size_t)MT * DFF * 2 <= WS_Y2 && WS_Y2 + (size_t)MT * DM * 4 <= WS_Y2B && WS_Y2B + (size_t)MT * DM * 2 <= WS_UP && WS_UP + (size_t)MT * 768 * 4 <= WS_Y3 &&
              WS_Y3 + (size_t)MT * DM * 4 <= WS_Y3B && WS_Y3B + (size_t)MT * DM * 2 <= WS_QB && WS_QB + (size_t)MP * 768 * 2 <= WS_XQB && WS_XQB + (size_t)MP * 256 * 2 <= WS_KSB, "d_ws map");
constexpr int CW_TMO = 0, CW_BAR = 4096, CW_SSQ = 16384, SSQ_STRIDE = 34816, CW_B1EFF = 131072;
static_assert(CW_SSQ + 3 * SSQ_STRIDE <= CW_B1EFF && (CW_B1EFF + 256) * 4 <= (int)CTL_ZERO_BYTES, "ctl map");
constexpr int RING_OFF = 0, RING_BYTES = 131072, LDSCTL_OFF = RING_BYTES, MISC_OFF = LDSCTL_OFF + 320, LDS_BYTES = 147456;
constexpr int NWAVES = 8;

#define GAS __attribute__((address_space(1)))
#define LAS __attribute__((address_space(3)))
typedef unsigned short bf16;
typedef unsigned v4u __attribute__((ext_vector_type(4)));
typedef unsigned v2u __attribute__((ext_vector_type(2)));
typedef float f32x4 __attribute__((ext_vector_type(4)));
#define LDS_WAIT() asm volatile("s_waitcnt lgkmcnt(0)" ::: "memory")
using pg8::cvt_pk_bf16;

__device__ __forceinline__ float wave_sum(float v) {
    v += __builtin_bit_cast(float, __builtin_amdgcn_mov_dpp(__builtin_bit_cast(int, v), 0x128, 0xf, 0xf, false));
    v += __builtin_bit_cast(float, __builtin_amdgcn_mov_dpp(__builtin_bit_cast(int, v), 0x124, 0xf, 0xf, false));
    v += __builtin_bit_cast(float, __builtin_amdgcn_mov_dpp(__builtin_bit_cast(int, v), 0x122, 0xf, 0xf, false));
    v += __builtin_bit_cast(float, __builtin_amdgcn_mov_dpp(__builtin_bit_cast(int, v), 0x121, 0xf, 0xf, false));
    const int vi = __builtin_bit_cast(int, v);
    return (__builtin_bit_cast(float, __builtin_amdgcn_readlane(vi, 0)) + __builtin_bit_cast(float, __builtin_amdgcn_readlane(vi, 16))) + (__builtin_bit_cast(float, __builtin_amdgcn_readlane(vi, 32)) + __builtin_bit_cast(float, __builtin_amdgcn_readlane(vi, 48)));
}
__device__ __forceinline__ float wave_max(float v) {
#pragma unroll
    for (int o = 1; o < 64; o <<= 1) v = fmaxf(v, __shfl_xor(v, o));
    return v;
}
__device__ __forceinline__ float fq_sum(float x) {
    int l_ = (int)__builtin_amdgcn_mbcnt_hi(~0u, __builtin_amdgcn_mbcnt_lo(~0u, 0u)); asm volatile("" : "+v"(l_));
    x += __builtin_bit_cast(float, __builtin_amdgcn_ds_bpermute((l_ ^ 16) << 2, __builtin_bit_cast(int, x)));
    x += __builtin_bit_cast(float, __builtin_amdgcn_ds_bpermute((l_ ^ 32) << 2, __builtin_bit_cast(int, x)));
    return x;
}
__device__ __forceinline__ float bf2f(unsigned short h) { return __uint_as_float((unsigned)h << 16); }
__device__ __forceinline__ float sigmoidf_(float x) { return 1.0f / (1.0f + __expf(-x)); }
__device__ __forceinline__ float gelu_tanh(float x) { const float y = 0.7978845608028654f * (x + 0.044715f * x * x * x); const float t = 1.0f - 2.0f / (__expf(2.0f * y) + 1.0f); return 0.5f * x * (1.0f + t); }

using pg8::Unit;
#define EPI_ROW(u, ai, wr, m, fr) ((u).pm * 256 + (ai) * 128 + (wr) * 64 + (m) * 16 + (fr))

constexpr int LDS_VTT = LDSCTL_OFF + 1024;
struct EpiInNsa {
    static constexpr bool PERM = true, AFTER_DRAIN = false;
    const float* ssq0; const float* qgain; const float* kgain; const float* xqgain;
    float* Qf; float* XQf; float* Gf; float* out; bf16* Qb; bf16* XQb; bf16* KSb; bf16* VSt; bf16* KWb; bf16* VWt; LAS unsigned char* lds;
    __device__ __forceinline__ void operator()(const f32x4 (&acc)[2][2][4][2], const Unit& u, int wr, int wc, int fr_in, int fq_in) const {
        int lane_ = fr_in + 16 * fq_in; asm volatile("" : "+v"(lane_)); const int fr = lane_ & 15, fq = lane_ >> 4;
        const int pn = u.pn;
        float sq8[2][4];
#pragma unroll
        for (int ai = 0; ai < 2; ++ai)
#pragma unroll
            for (int m = 0; m < 4; ++m) sq8[ai][m] = ssq0[EPI_ROW(u, ai, wr, m, fr)];
        __builtin_amdgcn_sched_barrier(0);
#pragma unroll
        for (int ai = 0; ai < 2; ++ai)
#pragma unroll
            for (int m = 0; m < 4; ++m) {
                const int row = EPI_ROW(u, ai, wr, m, fr);
                const float rstd = rsqrtf(sq8[ai][m] * (1.0f / DM) + EPS);
                float v[16]; float ss = 0.f;
#pragma unroll
                for (int bj = 0; bj < 2; ++bj)
#pragma unroll
                    for (int n = 0; n < 2; ++n)
#pragma unroll
                        for (int e = 0; e < 4; ++e) { const float x = acc[ai][bj][m][n][e] * rstd; v[bj * 8 + n * 4 + e] = x; ss += x * x; }
                ss = fq_sum(ss);
                const float hn = rsqrtf(ss * (1.0f / 64.0f) + EPS);
                const bool samp = row >= MP; const int rs = row - MP;
                if (pn < 3) {
                    const int h = 4 * pn + wc;
#pragma unroll
                    for (int bj = 0; bj < 2; ++bj) { const int d0 = 32 * bj + 8 * fq;
                        const f32x4 g0 = *(const f32x4*)(qgain + d0), g1 = *(const f32x4*)(qgain + d0 + 4);
                        const f32x4 a = (f32x4){v[bj * 8 + 0] * hn * g0[0], v[bj * 8 + 1] * hn * g0[1], v[bj * 8 + 2] * hn * g0[2], v[bj * 8 + 3] * hn * g0[3]};
                        const f32x4 b = (f32x4){v[bj * 8 + 4] * hn * g1[0], v[bj * 8 + 5] * hn * g1[1], v[bj * 8 + 6] * hn * g1[2], v[bj * 8 + 7] * hn * g1[3]};
                        if (samp) { float* dst = Qf + (size_t)row * 768 + h * 64 + d0; *(f32x4*)dst = a; *(f32x4*)(dst + 4) = b; }
                        else { v4u w; w.x = cvt_pk_bf16(a[0] * QSCALE_, a[1] * QSCALE_); w.y = cvt_pk_bf16(a[2] * QSCALE_, a[3] * QSCALE_); w.z = cvt_pk_bf16(b[0] * QSCALE_, b[1] * QSCALE_); w.w = cvt_pk_bf16(b[2] * QSCALE_, b[3] * QSCALE_);
                            *(v4u*)(Qb + (size_t)row * 768 + h * 64 + d0) = w; } }
                } else if (pn < 6) {
                    const int gidx = 4 * (pn - 3) + wc, i = gidx >> 1, g = gidx & 1; const bool nrm = (i == 2) || (i == 4);
#pragma unroll
                    for (int bj = 0; bj < 2; ++bj) { const int d0 = 32 * bj + 8 * fq; float o8[8];
                        const f32x4 kg0 = *(const f32x4*)(kgain + d0), kg1 = *(const f32x4*)(kgain + d0 + 4);
#pragma unroll
                        for (int e = 0; e < 8; ++e) { const float gk_ = e < 4 ? kg0[e & 3] : kg1[e & 3]; o8[e] = nrm ? v[bj * 8 + e] * hn * gk_ : v[bj * 8 + e]; }
                        const f32x4 a = (f32x4){o8[0], o8[1], o8[2], o8[3]}, b = (f32x4){o8[4], o8[5], o8[6], o8[7]};
                        if (i < 4) {
                            float* dst = samp ? out + O_KVS + ((size_t)rs * 4 + i) * 128 + g * 64 + d0 : out + O_KVP + ((size_t)row * 4 + i) * 128 + g * 64 + d0;
                            *(f32x4*)dst = a; *(f32x4*)(dst + 4) = b;
                        } else {
                            if (samp) { const int b_ = rs >> 3, t = rs & 7; float* dst = out + O_WINS + (((size_t)b_ * 512 + 504 + t) * 2 + (i - 4)) * 128 + g * 64 + d0; *(f32x4*)dst = a; *(f32x4*)(dst + 4) = b; }
                            else { const int b_ = row >> 12, t = row & 4095;
                                if (t >= SEQ - 512) { float* d2 = out + O_WINP + (((size_t)b_ * 512 + (t - (SEQ - 512))) * 2 + (i - 4)) * 128 + g * 64 + d0; *(f32x4*)d2 = a; *(f32x4*)(d2 + 4) = b; } }
                        }
                        if (!samp && i >= 2) {
                            const int b_ = row >> 12, t = row & 4095, bg = b_ * 2 + g;
                            if ((i & 1) == 0) { v4u w; w.x = cvt_pk_bf16(o8[0], o8[1]); w.y = cvt_pk_bf16(o8[2], o8[3]); w.z = cvt_pk_bf16(o8[4], o8[5]); w.w = cvt_pk_bf16(o8[6], o8[7]);
                                *(v4u*)((i == 2 ? KSb : KWb) + ((size_t)bg * SEQ + t) * 64 + d0) = w; }
                            else {
                                LAS bf16* vl = (LAS bf16*)(lds + LDS_VTT + (wr * 2 + (wc & 1)) * 2048) + d0 * 16 + fr;
#pragma unroll
                                for (int e = 0; e < 8; ++e) vl[e * 16] = (bf16)(cvt_pk_bf16(o8[e], 0.f) & 0xffffu); }
                        }
                    }
                    if (!samp && (i == 3 || i == 5)) {
                        asm volatile("s_waitcnt lgkmcnt(0)" ::: "memory");
                        const LAS v4u* vr = (const LAS v4u*)(lds + LDS_VTT + (wr * 2 + (wc & 1)) * 2048 + lane_ * 32);
                        const v4u x0 = vr[0], x1 = vr[1];
                        const int r0 = row - fr, bg = (r0 >> 12) * 2 + g;
                        bf16* vt = (i == 3 ? VSt : VWt) + ((size_t)bg * 64 + lane_) * SEQ + (r0 & 4095);
                        *(v4u*)vt = x0; *(v4u*)(vt + 8) = x1;
                        asm volatile("s_waitcnt lgkmcnt(0)" ::: "memory");
                    }
                } else if (pn == 6) {
#pragma unroll
                    for (int bj = 0; bj < 2; ++bj) { const int d0 = 32 * bj + 8 * fq;
                        const f32x4 g0 = *(const f32x4*)(xqgain + d0), g1 = *(const f32x4*)(xqgain + d0 + 4);
                        const f32x4 a = (f32x4){v[bj * 8 + 0] * hn * g0[0], v[bj * 8 + 1] * hn * g0[1], v[bj * 8 + 2] * hn * g0[2], v[bj * 8 + 3] * hn * g0[3]};
                        const f32x4 b = (f32x4){v[bj * 8 + 4] * hn * g1[0], v[bj * 8 + 5] * hn * g1[1], v[bj * 8 + 6] * hn * g1[2], v[bj * 8 + 7] * hn * g1[3]};
                        if (samp) { float* dst = XQf + (size_t)row * 256 + wc * 64 + d0; *(f32x4*)dst = a; *(f32x4*)(dst + 4) = b; }
                        else { v4u w; w.x = cvt_pk_bf16(a[0] * QSCALE_, a[1] * QSCALE_); w.y = cvt_pk_bf16(a[2] * QSCALE_, a[3] * QSCALE_); w.z = cvt_pk_bf16(b[0] * QSCALE_, b[1] * QSCALE_); w.w = cvt_pk_bf16(b[2] * QSCALE_, b[3] * QSCALE_);
                            *(v4u*)(XQb + (size_t)row * 256 + wc * 64 + d0) = w; } }
                } else {
                    if (wc == 0) {
#pragma unroll
                        for (int bj = 0; bj < 2; ++bj) { const int d0 = 32 * bj + 8 * fq; float* dst = Gf + (size_t)row * 64 + d0;
                            *(f32x4*)dst = (f32x4){sigmoidf_(v[bj * 8 + 0]), sigmoidf_(v[bj * 8 + 1]), sigmoidf_(v[bj * 8 + 2]), sigmoidf_(v[bj * 8 + 3])};
                            *(f32x4*)(dst + 4) = (f32x4){sigmoidf_(v[bj * 8 + 4]), sigmoidf_(v[bj * 8 + 5]), sigmoidf_(v[bj * 8 + 6]), sigmoidf_(v[bj * 8 + 7])}; }
                    }
                }
            }
    }
};

struct EpiMemKV {
    static constexpr bool PERM = true, AFTER_DRAIN = false;
    const float* xkgain; float* out; bf16* MKb; bf16* MVt;
    __device__ __forceinline__ void operator()(const f32x4 (&acc)[2][2][4][2], const Unit& u, int wr, int wc, int fr_in, int fq_in) const {
        int lane_ = fr_in + 16 * fq_in; asm volatile("" : "+v"(lane_)); const int fr = lane_ & 15, fq = lane_ >> 4;
        const int layer = u.pn >> 1, kv = u.pn & 1;
#pragma unroll
        for (int ai = 0; ai < 2; ++ai)
#pragma unroll
            for (int m = 0; m < 4; ++m) {
                const int row = EPI_ROW(u, ai, wr, m, fr);
                float v[16]; float ss = 0.f;
#pragma unroll
                for (int bj = 0; bj < 2; ++bj)
#pragma unroll
                    for (int n = 0; n < 2; ++n)
#pragma unroll
                        for (int e = 0; e < 4; ++e) { const float x = acc[ai][bj][m][n][e]; v[bj * 8 + n * 4 + e] = x; ss += x * x; }
                ss = fq_sum(ss);
                const float hn = rsqrtf(ss * (1.0f / 64.0f) + EPS);
#pragma unroll
                for (int bj = 0; bj < 2; ++bj) { const int d0 = 32 * bj + 8 * fq; float o8[8];
                    const f32x4 kg0 = *(const f32x4*)(xkgain + layer * 64 + d0), kg1 = *(const f32x4*)(xkgain + layer * 64 + d0 + 4);
#pragma unroll
                    for (int e = 0; e < 8; ++e) { const float gk_ = e < 4 ? kg0[e & 3] : kg1[e & 3]; o8[e] = (kv == 0) ? v[bj * 8 + e] * hn * gk_ : v[bj * 8 + e]; }
                    float* dst = out + O_MKV + (((size_t)layer * NB * NMEM + row) * 2 + kv) * 256 + wc * 64 + d0;
                    *(f32x4*)dst = (f32x4){o8[0], o8[1], o8[2], o8[3]}; *(f32x4*)(dst + 4) = (f32x4){o8[4], o8[5], o8[6], o8[7]};
                    const int bh = (layer * 32 + (row >> 8) * 4 + wc), mtok = row & 255;
                    if (kv == 0) { v4u w; w.x = cvt_pk_bf16(o8[0], o8[1]); w.y = cvt_pk_bf16(o8[2], o8[3]); w.z = cvt_pk_bf16(o8[4], o8[5]); w.w = cvt_pk_bf16(o8[6], o8[7]); *(v4u*)(MKb + ((size_t)bh * NMEM + mtok) * 64 + d0) = w; }
                    else { bf16* vt = MVt + ((size_t)bh * 64 + d0) * NMEM + mtok;
#pragma unroll
                        for (int e = 0; e < 8; ++e) vt[(size_t)e * NMEM] = (bf16)(cvt_pk_bf16(o8[e], 0.f) & 0xffffu); } }
            }
    }
};

struct EpiCmp1 {
    static constexpr bool PERM = true, AFTER_DRAIN = false;
    int which; const float* b1; const float* b1eff; float* H1;
    __device__ __forceinline__ void operator()(const f32x4 (&acc)[2][2][4][2], const Unit& u, int wr, int wc, int fr_in, int fq_in) const {
        int lane_ = fr_in + 16 * fq_in; asm volatile("" : "+v"(lane_)); const int fr = lane_ & 15, fq = lane_ >> 4;
        const int n0 = 32 * wc + 8 * fq; float bb[8];
#pragma unroll
        for (int e = 0; e < 8; ++e) bb[e] = b1[which * 128 + n0 + e] + b1eff[which * 128 + n0 + e];
#pragma unroll
        for (int ai = 0; ai < 2; ++ai)
#pragma unroll
            for (int m = 0; m < 4; ++m) {
                const int row = EPI_ROW(u, ai, wr, m, fr);
                float* dst = H1 + ((size_t)which * CMP_ROWS + row) * 128 + n0;
                f32x4 a, b;
#pragma unroll
                for (int e = 0; e < 4; ++e) { a[e] = gelu_tanh(acc[ai][0][m][0][e] + bb[e]); b[e] = gelu_tanh(acc[ai][0][m][1][e] + bb[4 + e]); }
                *(f32x4*)dst = a; *(f32x4*)(dst + 4) = b;
            }
    }
};

template <bool HALF>
struct EpiResidT {
    static constexpr bool PERM = true, AFTER_DRAIN = false;
    const bf16* baseB; float* outF; bf16* outB; float* ssq;
    __device__ __forceinline__ void operator()(const f32x4 (&acc)[2][2][4][2], const Unit& u, int wr, int wc, int fr_in, int fq_in) const {
        int lane_ = fr_in + 16 * fq_in; asm volatile("" : "+v"(lane_)); const int fr = lane_ & 15, fq = lane_ >> 4;
#pragma unroll
        for (int ai = 0; ai < 2; ++ai) {
          v4u bs[4][HALF ? 1 : 2];
#pragma unroll
          for (int m = 0; m < 4; ++m) { const int row = EPI_ROW(u, ai, wr, m, fr);
#pragma unroll
              for (int bj = 0; bj < (HALF ? 1 : 2); ++bj) { const int c0 = (HALF ? u.pn * 128 : u.pn * 256 + bj * 128) + wc * 32 + 8 * fq; bs[m][bj] = *(const v4u*)((const char*)baseB + (unsigned)(row * DM + c0) * 2u); } }
          __builtin_amdgcn_sched_barrier(0);
#pragma unroll
            for (int m = 0; m < 4; ++m) {
                const int row = EPI_ROW(u, ai, wr, m, fr);
                float ss = 0.f;
#pragma unroll
                for (int bj = 0; bj < (HALF ? 1 : 2); ++bj) { const int c0 = (HALF ? u.pn * 128 : u.pn * 256 + bj * 128) + wc * 32 + 8 * fq;
                    const v4u bw = bs[m][bj];
                    const f32x4 b0 = (f32x4){__uint_as_float(bw.x << 16), __uint_as_float(bw.x & 0xffff0000u), __uint_as_float(bw.y << 16), __uint_as_float(bw.y & 0xffff0000u)};
                    const f32x4 b1 = (f32x4){__uint_as_float(bw.z << 16), __uint_as_float(bw.z & 0xffff0000u), __uint_as_float(bw.w << 16), __uint_as_float(bw.w & 0xffff0000u)};
                    const f32x4 y0 = b0 + acc[ai][bj][m][0], y1 = b1 + acc[ai][bj][m][1];
                    if (outF) { *(f32x4*)(outF + (size_t)row * DM + c0) = y0; *(f32x4*)(outF + (size_t)row * DM + c0 + 4) = y1; }
                    if (outB) { v4u w; w.x = cvt_pk_bf16(y0[0], y0[1]); w.y = cvt_pk_bf16(y0[2], y0[3]); w.z = cvt_pk_bf16(y1[0], y1[1]); w.w = cvt_pk_bf16(y1[2], y1[3]);
                        *(v4u*)((char*)outB + (unsigned)(row * DM + c0) * 2u) = w;
                        ss += (y0[0] * y0[0] + y0[1] * y0[1]) + (y0[2] * y0[2] + y0[3] * y0[3]) + (y1[0] * y1[0] + y1[1] * y1[1]) + (y1[2] * y1[2] + y1[3] * y1[3]); } }
                if (outB) { ss = fq_sum(ss); if (fq == 0) atomicAdd(ssq + row, ss); }
            }
        }
    }
};

constexpr int LDS_HALO = LDSCTL_OFF + 1024, LDS_CWL = LDS_HALO + 4 * 2 * 256 * 4;
static_assert(LDS_CWL + 4 * 256 * 4 <= LDS_BYTES, "epilogue LDS");
__device__ __forceinline__ float dpp_ror1(float x) { return __builtin_bit_cast(float, __builtin_amdgcn_mov_dpp(__builtin_bit_cast(int, x), 0x121, 0xf, 0xf, false)); }
__device__ __forceinline__ float dpp_ror2(float x) { return __builtin_bit_cast(float, __builtin_amdgcn_mov_dpp(__builtin_bit_cast(int, x), 0x122, 0xf, 0xf, false)); }
struct EpiUpConv {
    static constexpr bool PERM = true, AFTER_DRAIN = false;
    const float* ssq; bf16* ACT; float* UB; float* US; float* convP; const float* cw; const float* cb; LAS unsigned char* lds;
    __device__ __forceinline__ void operator()(const f32x4 (&acc_in)[2][2][4][2], const Unit& u, int wr, int wc, int fr_in, int fq_in) const {
        LAS float* HALO = (LAS float*)(lds + LDS_HALO); LAS float* CWL = (LAS float*)(lds + LDS_CWL);
        int lane_ = fr_in + 16 * fq_in; asm volatile("" : "+v"(lane_));
        const int fr = lane_ & 15, fq = lane_ >> 4;
        const int tid = (wr * 4 + wc) * 64 + lane_, pn = u.pn; const bool samp_panel = u.pm >= MP / 256;
        f32x4 (&acc)[2][2][4][2] = const_cast<f32x4 (&)[2][2][4][2]>(acc_in);
        float cpv[2], sq8[2][4];
#pragma unroll
        for (int i = 0; i < 2; ++i) { const int id = tid * 2 + i, tc = id >> 2, k = id & 3, chn = ((tc >> 7) ? DFF : 0) + 128 * pn + (tc & 127); const float* p_ = k < 3 ? cw + (size_t)k * NUP + chn : cb + chn; cpv[i] = *p_; }
#pragma unroll
        for (int ai = 0; ai < 2; ++ai)
#pragma unroll
            for (int m = 0; m < 4; ++m) sq8[ai][m] = *(const float*)((const char*)ssq + (unsigned)EPI_ROW(u, ai, wr, m, fr) * 4u);
        __builtin_amdgcn_sched_barrier(0);
#pragma unroll
        for (int ai = 0; ai < 2; ++ai)
#pragma unroll
            for (int m = 0; m < 4; ++m) { const float rs = rsqrtf(sq8[ai][m] * (1.0f / DM) + EPS);
#pragma unroll
                for (int bj = 0; bj < 2; ++bj) { acc[ai][bj][m][0] *= rs; acc[ai][bj][m][1] *= rs; } }
#pragma unroll
        for (int i = 0; i < 2; ++i) CWL[tid * 2 + i] = cpv[i];
        if (fr >= 14) {
#pragma unroll
            for (int ai = 0; ai < 2; ++ai)
#pragma unroll
                for (int bj = 0; bj < 2; ++bj) { LAS float* hp = HALO + ((ai * 2 + wr) * 2 + (fr - 14)) * 256 + 128 * bj + 32 * wc + 8 * fq;
                    *(LAS f32x4*)hp = acc[ai][bj][3][0]; *(LAS f32x4*)(hp + 4) = acc[ai][bj][3][1]; }
        }
        asm volatile("s_waitcnt lgkmcnt(0)" ::: "memory"); __builtin_amdgcn_s_barrier(); asm volatile("" ::: "memory");
        const int tca = 32 * wc + 8 * fq;
        if (samp_panel) {
#pragma unroll
            for (int ai = 0; ai < 2; ++ai)
#pragma unroll
                for (int m = 0; m < 4; ++m) { float* us = US + (size_t)(EPI_ROW(u, ai, wr, m, fr) - MP) * NUP + 128 * pn + tca;
#pragma unroll
                    for (int bj = 0; bj < 2; ++bj) { *(f32x4*)(us + bj * DFF) = acc[ai][bj][m][0]; *(f32x4*)(us + bj * DFF + 4) = acc[ai][bj][m][1]; } }
            return;
        }
        const bool seq_start = (u.pm & 15) == 0;
        float pu[2][8];
#pragma unroll
        for (int ai = 0; ai < 2; ++ai)
#pragma unroll
            for (int m = 0; m < 4; ++m) {
                const int row = EPI_ROW(u, ai, wr, m, fr);
                if (m == 0) { const int blk = ai * 2 + wr;
#pragma unroll
                    for (int bj = 0; bj < 2; ++bj)
#pragma unroll
                        for (int e8 = 0; e8 < 8; ++e8) pu[bj][e8] = (blk > 0 && fr >= 14) ? HALO[((blk - 1) * 2 + (fr - 14)) * 256 + 128 * bj + tca + e8] : 0.f; }
                float res[8];
#pragma unroll
                for (int e8 = 0; e8 < 8; ++e8) {
                    const f32x4 wa = *(const LAS f32x4*)(CWL + (tca + e8) * 4), wv = *(const LAS f32x4*)(CWL + (128 + tca + e8) * 4);
                    const float ua = acc[ai][0][m][e8 >> 2][e8 & 3], uv = acc[ai][1][m][e8 >> 2][e8 & 3];
                    const float t1a = fr == 15 ? pu[0][e8] : ua, t2a = fr >= 14 ? pu[0][e8] : ua, t1v = fr == 15 ? pu[1][e8] : uv, t2v = fr >= 14 ? pu[1][e8] : uv;
                    const float x1a = dpp_ror1(t1a), x2a = dpp_ror2(t2a), x1v = dpp_ror1(t1v), x2v = dpp_ror2(t2v);
                    const float ya = wa[3] + wa[0] * x2a + wa[1] * x1a + wa[2] * ua, yv = wv[3] + wv[0] * x2v + wv[1] * x1v + wv[2] * uv;
                    res[e8] = ya * __builtin_amdgcn_rcpf(1.0f + __expf(-ya)) * yv;
                    if (e8 & 1) asm volatile("" ::: "memory");
                }
#pragma unroll
                for (int bj = 0; bj < 2; ++bj)
#pragma unroll
                    for (int e8 = 0; e8 < 8; ++e8) pu[bj][e8] = acc[ai][bj][m][e8 >> 2][e8 & 3];
                const bool skip = !seq_start && ai == 0 && wr == 0 && m == 0 && fr < 2;
                v4u w; w.x = cvt_pk_bf16(res[0], res[1]); w.y = cvt_pk_bf16(res[2], res[3]); w.z = cvt_pk_bf16(res[4], res[5]); w.w = cvt_pk_bf16(res[6], res[7]);
                if (!skip) *(v4u*)((char*)ACT + (unsigned)(row * DFF + 128 * pn + tca) * 2u) = w;
                asm volatile("" ::: "memory");
            }
#pragma unroll
        for (int ai = 0; ai < 2; ++ai)
#pragma unroll
            for (int m = 0; m < 4; m += 3) { if ((ai == 0 && m == 0) || (ai == 1 && m == 3)) {
                const int row = EPI_ROW(u, ai, wr, m, fr); const int rt = row & 255, t = row & 4095;
                float* st = (t >= SEQ - 2) ? convP + ((size_t)(row >> 12) * 2 + (t - (SEQ - 2))) * NUP : nullptr;
                float* ub = (rt < 2 || rt >= 254) ? UB + ((size_t)u.pm * 4 + (rt < 2 ? rt : rt - 252)) * NUP : nullptr;
#pragma unroll
                for (int bj = 0; bj < 2; ++bj) { const int c0 = bj * DFF + 128 * pn + tca; const f32x4 y0 = acc[ai][bj][m][0], y1 = acc[ai][bj][m][1];
                    if (st) { *(f32x4*)(st + c0) = y0; *(f32x4*)(st + c0 + 4) = y1; }
                    if (ub) { *(f32x4*)(ub + c0) = y0; *(f32x4*)(ub + c0 + 4) = y1; } } } }
    }
};

struct EpiInPool {
    static constexpr bool PERM = true, AFTER_DRAIN = false;
    const float* ssq; const float* xqgain; float* UP; float* XQf; float* out; bf16* XQb;
    __device__ __forceinline__ void operator()(const f32x4 (&acc)[2][2][4][2], const Unit& u, int wr, int wc, int fr_in, int fq_in) const {
        int lane_ = fr_in + 16 * fq_in; asm volatile("" : "+v"(lane_)); const int fr = lane_ & 15, fq = lane_ >> 4;
        const int pn = u.pn;
        float sq8[2][4];
#pragma unroll
        for (int ai = 0; ai < 2; ++ai)
#pragma unroll
            for (int m = 0; m < 4; ++m) sq8[ai][m] = ssq[EPI_ROW(u, ai, wr, m, fr)];
        __builtin_amdgcn_sched_barrier(0);
#pragma unroll
        for (int ai = 0; ai < 2; ++ai)
#pragma unroll
            for (int m = 0; m < 4; ++m) {
                const int row = EPI_ROW(u, ai, wr, m, fr);
                const float rstd = rsqrtf(sq8[ai][m] * (1.0f / DM) + EPS);
                float v[16]; float ss = 0.f;
#pragma unroll
                for (int bj = 0; bj < 2; ++bj)
#pragma unroll
                    for (int n = 0; n < 2; ++n)
#pragma unroll
                        for (int e = 0; e < 4; ++e) { const float x = acc[ai][bj][m][n][e] * rstd; v[bj * 8 + n * 4 + e] = x; ss += x * x; }
                if (pn < 3) {
                    float* st = nullptr;
                    if (row >= MP) { const int rs = row - MP; st = out + O_POOLS + ((size_t)(rs >> 3) * 15 + 7 + (rs & 7)) * 768; }
                    else { const int t = row & 4095; if (t >= SEQ - 15) st = out + O_POOLP + ((size_t)(row >> 12) * 15 + (t - (SEQ - 15))) * 768; }
#pragma unroll
                    for (int bj = 0; bj < 2; ++bj) { const int c0 = pn * 256 + wc * 64 + 32 * bj + 8 * fq;
                        const f32x4 a = (f32x4){v[bj * 8 + 0], v[bj * 8 + 1], v[bj * 8 + 2], v[bj * 8 + 3]}, b = (f32x4){v[bj * 8 + 4], v[bj * 8 + 5], v[bj * 8 + 6], v[bj * 8 + 7]};
                        *(f32x4*)(UP + (size_t)row * 768 + c0) = a; *(f32x4*)(UP + (size_t)row * 768 + c0 + 4) = b;
                        if (st) { *(f32x4*)(st + c0) = a; *(f32x4*)(st + c0 + 4) = b; } }
                } else {
                    ss = fq_sum(ss);
                    const float hn = rsqrtf(ss * (1.0f / 64.0f) + EPS);
#pragma unroll
                    for (int bj = 0; bj < 2; ++bj) { const int d0 = 32 * bj + 8 * fq;
                        const f32x4 g0 = *(const f32x4*)(xqgain + d0), g1 = *(const f32x4*)(xqgain + d0 + 4);
                        const f32x4 a = (f32x4){v[bj * 8 + 0] * hn * g0[0], v[bj * 8 + 1] * hn * g0[1], v[bj * 8 + 2] * hn * g0[2], v[bj * 8 + 3] * hn * g0[3]};
                        const f32x4 b = (f32x4){v[bj * 8 + 4] * hn * g1[0], v[bj * 8 + 5] * hn * g1[1], v[bj * 8 + 6] * hn * g1[2], v[bj * 8 + 7] * hn * g1[3]};
                        if (row >= MP) { float* dst = XQf + (size_t)row * 256 + wc * 64 + d0; *(f32x4*)dst = a; *(f32x4*)(dst + 4) = b; }
                        else { v4u w; w.x = cvt_pk_bf16(a[0] * QSCALE_, a[1] * QSCALE_); w.y = cvt_pk_bf16(a[2] * QSCALE_, a[3] * QSCALE_); w.z = cvt_pk_bf16(b[0] * QSCALE_, b[1] * QSCALE_); w.w = cvt_pk_bf16(b[2] * QSCALE_, b[3] * QSCALE_);
                            *(v4u*)(XQb + (size_t)row * 256 + wc * 64 + d0) = w; } }
                }
            }
    }
};

struct Args { const void* in[N_IN]; float* out; unsigned char* ws; int ph_lo, ph_hi; };
struct Frame {
    LAS unsigned char* lds; int tid, lane, wave, G, gw, NGW;
    const void* const* in; float* out; unsigned char* ws;
};
#define FIN(F, i) ((const float*)(F).in[i])

__device__ __forceinline__ void tr_item(const float* W, int ldw, const float* gain, bf16* Bt, int Kdim, int k0, int n0, int srccol0, int ncols_valid, LAS float* scr, int lane) {
    const int j = lane & 31, kh = lane >> 5; const bool ok = j < ncols_valid;
    const float* wp = W + (size_t)(k0 + kh) * ldw + (ok ? srccol0 + j : 0);
    float v[32];
#pragma unroll
    for (int i = 0; i < 32; ++i) v[i] = wp[(size_t)(2 * i) * ldw];
    __builtin_amdgcn_sched_barrier(0);
#pragma unroll
    for (int i = 0; i < 32; ++i) scr[(2 * i + kh) * 33 + j] = ok ? v[i] : 0.f;
    LDS_WAIT(); asm volatile("" ::: "memory");
    const int c = lane & 7;
    f32x4 g0 = (f32x4){1.f, 1.f, 1.f, 1.f}, g1 = g0;
    if (gain) { g0 = *(const f32x4*)(gain + k0 + 8 * c); g1 = *(const f32x4*)(gain + k0 + 8 * c + 4); }
#pragma unroll
    for (int jj = 0; jj < 4; ++jj) { const int n = (lane >> 3) + 8 * jj; const LAS float* s = scr + (8 * c) * 33 + n;
        v4u o; o.x = cvt_pk_bf16(s[0 * 33] * g0[0], s[1 * 33] * g0[1]); o.y = cvt_pk_bf16(s[2 * 33] * g0[2], s[3 * 33] * g0[3]); o.z = cvt_pk_bf16(s[4 * 33] * g1[0], s[5 * 33] * g1[1]); o.w = cvt_pk_bf16(s[6 * 33] * g1[2], s[7 * 33] * g1[3]);
        *(v4u*)(Bt + (size_t)(n0 + n) * Kdim + k0 + 8 * c) = o; }
    LDS_WAIT(); asm volatile("" ::: "memory");
}
__device__ __forceinline__ int hpw_src(int n) { return (n & ~255) + ((n >> 5) & 3) * 64 + ((n >> 7) & 1) * 32 + (n & 31); }

__device__ __forceinline__ void tr_matrix(Frame& F, int& cursor, const float* W, int ldw, int ncols, const float* gain, bf16* Bt, int N, int K, int mode, LAS float* scr) {
    const int nkb = K / 64, nnb = N / 32, items = nkb * nnb;
    int first = (F.gw - (cursor % F.NGW) + F.NGW) % F.NGW;
    for (int it = first; it < items; it += F.NGW) {
        const int kb = it / nnb, nb = it % nnb, n0 = nb * 32; int src = (mode == 1 || mode == 2) ? hpw_src(n0) : n0;
        int nv = ncols - src; nv = nv < 0 ? 0 : (nv > 32 ? 32 : nv);
        if (mode == 3) { src = ((n0 >> 7) & 1) * DFF + 128 * (n0 >> 8) + (n0 & 127); nv = 32; }
        if (mode == 2) {
            if (src >= 1792) { const int off = src - 1792; nv = 36 - off; nv = nv < 0 ? 0 : (nv > 32 ? 32 : nv); src = 1536 + off; }
            else if (src >= 1536) { src += 36; nv = 32; }
            else nv = 32; }
        tr_item(W, ldw, gain, Bt, K, kb * 64, n0, src, nv, scr, F.lane);
    }
    cursor += items;
}

__device__ __forceinline__ void p0_prologue(Frame& F, bool first) {
    LAS float* scr = (LAS float*)(F.lds + RING_OFF + F.wave * 16384);
    unsigned char* ws = F.ws;
    int cur = 0;
    tr_matrix(F, cur, FIN(F, I_WINNSA), NSA_IN, NSA_IN, FIN(F, I_GMIX), (bf16*)(ws + WS_WIN0), NIN0, DM, 2, scr);
    tr_matrix(F, cur, FIN(F, I_WINPOOL), DM, DM, FIN(F, I_GMIX) + DM, (bf16*)(ws + WS_WIN1), DM, DM, 1, scr);
    tr_matrix(F, cur, FIN(F, I_WMEMKV), 512, 512, FIN(F, I_GMEM), (bf16*)(ws + WS_WMEM), 512, DM, 1, scr);
    tr_matrix(F, cur, FIN(F, I_WMEMKV) + (size_t)DM * 512, 512, 512, FIN(F, I_GMEM) + DM, (bf16*)(ws + WS_WMEM) + (size_t)512 * DM, 512, DM, 1, scr);
    tr_matrix(F, cur, FIN(F, I_WOUT), DM, DM, nullptr, (bf16*)(ws + WS_WOUT), DM, DM, 0, scr);
    {
        const float* W = FIN(F, I_WOUT) + (size_t)DM * DM + (size_t)768 * DM; bf16* Bt = (bf16*)(ws + WS_WOUT) + (size_t)DM * DM + 768;
        const int nkb = 4, nnb = DM / 32, items = nkb * nnb; int first = (F.gw - (cur % F.NGW) + F.NGW) % F.NGW;
        for (int it = first; it < items; it += F.NGW) { const int kb = it / nnb, nb = it % nnb; tr_item(W, DM, nullptr, Bt, DM, kb * 64, nb * 32, nb * 32, 32, scr, F.lane); }
        cur += items;
    }
    for (int l = 0; l < 2; ++l) tr_matrix(F, cur, FIN(F, I_WUP) + (size_t)l * DM * NUP, NUP, NUP, FIN(F, I_GFFN) + l * DM, (bf16*)(ws + WS_WUP) + (size_t)l * NUP * DM, NUP, DM, 3, scr);
    for (int l = 0; l < 2; ++l) tr_matrix(F, cur, FIN(F, I_WDOWN) + (size_t)l * DFF * DM, DM, DM, nullptr, (bf16*)(ws + WS_WDOWN) + (size_t)l * DM * DFF, DM, DFF, 0, scr);
    for (int w = 0; w < 2; ++w) tr_matrix(F, cur, FIN(F, I_CW1) + (size_t)w * 4096 * 128, 128, 128, nullptr, (bf16*)(ws + WS_WC1B) + (size_t)w * 256 * 4096, 128, 4096, 0, scr);
    {
        const float* Wg = FIN(F, I_WPG); const float* sc = FIN(F, I_PSCALE); const float* wo = FIN(F, I_WOUT) + (size_t)DM * DM; bf16* Bt = (bf16*)(ws + WS_WOUT) + (size_t)DM * DM;
        for (int task = F.gw; task < 96 * 16; task += F.NGW) { const int kc0 = (task >> 4) * 8, n = (task & 15) * 64 + F.lane, g = kc0 / 192;
            const float* wr = Wg + (size_t)kc0 * 192;
            const float* wop = wo + (size_t)(g * 192) * DM + n; const float* scp = sc + g * 192;
            float a[8];
#pragma unroll
            for (int r = 0; r < 8; ++r) a[r] = 0.f;
            { f32x4 t[6];
#pragma unroll
              for (int q = 0; q < 6; ++q) t[q] = *(const f32x4*)(wr + (q * 64 + F.lane) * 4);
#pragma unroll
              for (int q = 0; q < 6; ++q) { const int e = (q * 64 + F.lane) * 4, d = e % 192; const f32x4 s4 = *(const f32x4*)(scp + d); *(LAS f32x4*)(scr + e) = t[q] * s4; }
              LDS_WAIT(); asm volatile("" ::: "memory"); }
#pragma unroll 1
            for (int d0 = 0; d0 < 192; d0 += 16) { float x[16];
#pragma unroll
                for (int dd = 0; dd < 16; ++dd) x[dd] = wop[(size_t)(d0 + dd) * DM];
                __builtin_amdgcn_sched_barrier(0);
#pragma unroll
                for (int d4 = 0; d4 < 4; ++d4) {
#pragma unroll
                    for (int r = 0; r < 8; ++r) { const f32x4 w4 = *(const LAS f32x4*)(scr + r * 192 + d0 + 4 * d4); a[r] += (w4[0] * x[4 * d4] + w4[1] * x[4 * d4 + 1]) + (w4[2] * x[4 * d4 + 2] + w4[3] * x[4 * d4 + 3]); }
                    __builtin_amdgcn_sched_barrier(0); }
            }
            LDS_WAIT(); asm volatile("" ::: "memory");
            v4u o; o.x = cvt_pk_bf16(a[0], a[1]); o.y = cvt_pk_bf16(a[2], a[3]); o.z = cvt_pk_bf16(a[4], a[5]); o.w = cvt_pk_bf16(a[6], a[7]);
            *(v4u*)(Bt + (size_t)n * DM + kc0) = o; }
    }
    {
        bf16* XB = (bf16*)(ws + WS_XB); float* ssq0 = (float*)(ws + WS_SSQ0);
        f32x4 v[8];
#define P0_LDX(dst, m2_) do { const int m_ = (m2_) * 2; const float* xr_ = m_ < MP ? FIN(F, I_XP) + (size_t)m_ * DM : FIN(F, I_XS) + (size_t)(m_ - MP) * DM; const f32x4* x4_ = (const f32x4*)xr_ + F.lane; _Pragma("unroll") for (int j = 0; j < 8; ++j) dst[j] = x4_[64 * j]; } while (0)
        if (F.gw < MT / 2) P0_LDX(v, F.gw);
#pragma unroll 1
        for (int m2 = F.gw; m2 < MT / 2; m2 += F.NGW) { const int m = m2 * 2;
            f32x4 vn[8]; const bool more = m2 + F.NGW < MT / 2;
            if (more) P0_LDX(vn, m2 + F.NGW);
            __builtin_amdgcn_sched_barrier(0);
            float s0 = 0.f, s1 = 0.f;
#pragma unroll
            for (int j = 0; j < 4; ++j) { s0 += (v[j][0] * v[j][0] + v[j][1] * v[j][1]) + (v[j][2] * v[j][2] + v[j][3] * v[j][3]); s1 += (v[4 + j][0] * v[4 + j][0] + v[4 + j][1] * v[4 + j][1]) + (v[4 + j][2] * v[4 + j][2] + v[4 + j][3] * v[4 + j][3]); }
            s0 = wave_sum(s0); s1 = wave_sum(s1); if (F.lane == 0) { ssq0[m] = s0; ssq0[m + 1] = s1; }
            v2u* o = (v2u*)(XB + (size_t)m * DM) + F.lane;
#pragma unroll
            for (int j = 0; j < 8; ++j) { v2u w; w.x = cvt_pk_bf16(v[j][0], v[j][1]); w.y = cvt_pk_bf16(v[j][2], v[j][3]); o[64 * j] = w; }
            if (more) {
#pragma unroll
                for (int j = 0; j < 8; ++j) v[j] = vn[j]; }
        }
#undef P0_LDX
    }
    {
        bf16* MN = (bf16*)(ws + WS_MEMN);
        for (int m = F.gw; m < NB * NMEM; m += F.NGW) {
            const f32x4* x4 = (const f32x4*)(FIN(F, I_MEMP) + (size_t)m * DM) + F.lane; f32x4 v[4]; float s = 0.f;
#pragma unroll
            for (int j = 0; j < 4; ++j) { v[j] = x4[64 * j]; s += (v[j][0] * v[j][0] + v[j][1] * v[j][1]) + (v[j][2] * v[j][2] + v[j][3] * v[j][3]); }
            s = wave_sum(s); const float r = rsqrtf(s * (1.0f / DM) + EPS);
            v2u* o = (v2u*)(MN + (size_t)m * DM) + F.lane;
#pragma unroll
            for (int j = 0; j < 4; ++j) { v2u w; w.x = cvt_pk_bf16(v[j][0] * r, v[j][1] * r); w.y = cvt_pk_bf16(v[j][2] * r, v[j][3] * r); o[64 * j] = w; }
        }
    }
    {
        const int gt = F.gw * 64 + F.lane, GT = F.NGW * 64;
        const f32x4* cw = (const f32x4*)FIN(F, I_CWIN); f32x4* ow = (f32x4*)(F.out + O_WINS);
#pragma unroll 1
        for (int idx0 = gt; idx0 < DBATCH * 504 * 64; idx0 += 8 * GT) { f32x4 t[8];
#pragma unroll
            for (int q = 0; q < 8; ++q) { int idx = idx0 + q * GT; idx = idx < DBATCH * 504 * 64 ? idx : gt; const int b = idx / (504 * 64), r = idx % (504 * 64); t[q] = __builtin_nontemporal_load(cw + (size_t)b * 512 * 64 + 8 * 64 + r); }
#pragma unroll
            for (int q = 0; q < 8; ++q) { const int idx = idx0 + q * GT; if (idx < DBATCH * 504 * 64) { const int b = idx / (504 * 64), r = idx % (504 * 64); ow[(size_t)b * 512 * 64 + r] = t[q]; } } }
        const f32x4* sp = (const f32x4*)FIN(F, I_SPOOL); f32x4* op = (f32x4*)(F.out + O_POOLS);
        for (int idx = gt; idx < DBATCH * 7 * 192; idx += GT) { const int b = idx / (7 * 192), r = idx % (7 * 192); op[(size_t)b * 15 * 192 + r] = sp[(size_t)b * 15 * 192 + 8 * 192 + r]; }
    }
    {
        float* b1eff = (float*)(ws + WS_CTL) + CW_B1EFF;
        for (int task = (F.gw + F.NGW - 1600 % F.NGW) % F.NGW; task < (first ? 2 * 64 : 0); task += F.NGW) { const int w = task >> 6, kc = task & 63;
            const float* pos = FIN(F, I_CPOS) + (size_t)w * 4096 + kc * 64; const float* w1 = FIN(F, I_CW1) + ((size_t)w * 4096 + kc * 64) * 128;
            float a0 = 0.f, a1 = 0.f;
#pragma unroll 16
            for (int k = 0; k < 64; ++k) { const float p = pos[k]; a0 += p * w1[k * 128 + F.lane]; a1 += p * w1[k * 128 + 64 + F.lane]; }
            atomicAdd(b1eff + w * 128 + F.lane, a0); atomicAdd(b1eff + w * 128 + 64 + F.lane, a1); }
    }
}

__device__ __forceinline__ void p3_compress2(Frame& F) {
    const float* H1 = (const float*)(F.ws + WS_H1); float* KC = (float*)(F.ws + WS_KC);
    static_assert(CMP_ROWS % 4 == 0 && CMP_ROWS_P % 4 == 0, "four rows per task");
#pragma unroll 1
    for (int task = F.gw; task < 2 * CMP_ROWS / 4; task += F.NGW) { const int w = task / (CMP_ROWS / 4), row0 = (task % (CMP_ROWS / 4)) * 4;
        const float* h = H1 + ((size_t)w * CMP_ROWS + row0) * 128; const float* w2 = FIN(F, I_CW2) + (size_t)w * 128 * 64 + F.lane;
        const float bias = FIN(F, I_CB2)[w * 64 + F.lane];
        int hv[4][2];
#pragma unroll
        for (int r = 0; r < 4; ++r) { hv[r][0] = __builtin_bit_cast(int, h[r * 128 + F.lane]); hv[r][1] = __builtin_bit_cast(int, h[r * 128 + 64 + F.lane]); }
        float a[4] = {bias, bias, bias, bias};
#pragma unroll
        for (int half = 0; half < 2; ++half) {
#pragma unroll 8
            for (int k = 0; k < 64; ++k) { const float wv = w2[(half * 64 + k) * 64];
#pragma unroll
                for (int r = 0; r < 4; ++r) a[r] += __builtin_bit_cast(float, __builtin_amdgcn_readlane(hv[r][half], k)) * wv; }
        }
#pragma unroll
        for (int r = 0; r < 4; ++r) { const int row = row0 + r; float av = a[r];
            if (w == 0) { const float ss = wave_sum(av * av); av = av * rsqrtf(ss * (1.0f / 64.0f) + EPS) * FIN(F, I_KG)[F.lane]; }
            KC[((size_t)w * CMP_ROWS + row) * 64 + F.lane] = av;
            if (row < CMP_ROWS_P) { const int bc = row >> 1, g = row & 1, b_ = bc >> 6, c = bc & 63, bg = b_ * 2 + g; const bf16 hb = (bf16)(cvt_pk_bf16(av, 0.f) & 0xffffu);
                if (w == 0) ((bf16*)(F.ws + WS_KCB))[((size_t)bg * 64 + c) * 64 + F.lane] = hb; else ((bf16*)(F.ws + WS_VCT))[((size_t)bg * 64 + F.lane) * 64 + c] = hb; } }
    }
}


namespace at {
typedef short bf16x8 __attribute__((ext_vector_type(8)));
constexpr int TILE_B = 8192;
constexpr int L_KBUF = 0, L_VBUF = 4 * TILE_B, L_IMP = 8 * TILE_B, L_SEL = L_IMP + 2 * 64 * 64 * 4, L_END = L_SEL + 512;
constexpr int BT_PITCH = 132;
constexpr float LOG2E = 1.4426950408889634f, QSCALE = 0.125f * LOG2E, NEG = -1e30f;
static_assert(L_END <= 100352, "attention LDS map (tables start at 100352)");

struct TileSrc { const bf16* k; const bf16* v; int vpitch; };
__device__ __forceinline__ v4u ldg16(const void* ubase, unsigned off) { return *(const v4u*)((const char*)ubase + off); }
__device__ __forceinline__ void tile_load(const TileSrc& t, int tid, v4u& kr, v4u& vr) {
    const int r = (tid >> 6) * 8 + (tid & 7), c = (tid >> 3) & 7;
    kr = ldg16(t.k, (unsigned)(r * 128 + c * 16));
    vr = ldg16(t.v, (unsigned)(r * t.vpitch * 2 + c * 16));
}
__device__ __forceinline__ void tile_store(LAS unsigned char* lds, int buf, int tid, const v4u& kr, const v4u& vr) {
    const int r = (tid >> 6) * 8 + (tid & 7), c = (tid >> 3) & 7, ds = c >> 2, fq = c & 3;
    const int kb = 2 * (r >> 5) + ((r >> 2) & 1), rho = 4 * ((r >> 3) & 3) + (r & 3);
    *(LAS v4u*)(lds + L_KBUF + buf * TILE_B + ((kb * 2 + ds) * 64 + rho + 16 * fq) * 16) = kr;
    *(LAS v4u*)(lds + L_VBUF + buf * TILE_B + (((r >> 4) * 2 + ds) * 64 + (r & 15) + 16 * fq) * 16) = vr;
}
__device__ __forceinline__ f32x4 splat4(float x) { return (f32x4){x, x, x, x}; }

template <int R, int KIND>
__device__ __forceinline__ void att_step(const LAS unsigned char* kb_, const LAS unsigned char* vb_, const bf16x8 (&qf)[R][2], const float (&cinit)[R], bool lane_on, int klo, int khi, int dbase, int qi,
                                         const LAS float* btab, const int (&hidx)[R], f32x4 (&o)[R][4], float (&lsum)[R], f32x4 (&impacc)[4], int lane) {
    const int fq = lane >> 4;
    const LAS unsigned char* kp = kb_ + lane * 16;
    const LAS unsigned char* vp = vb_ + lane * 16;
    bf16x8 kf[4][2];
#pragma unroll
    for (int kb = 0; kb < 4; ++kb)
#pragma unroll
        for (int ds = 0; ds < 2; ++ds) kf[kb][ds] = *(const LAS bf16x8*)(kp + (kb * 2 + ds) * 1024);
    bf16x8 pf[R][2];
#pragma unroll
    for (int r = 0; r < R; ++r) {
        f32x4 s[4]; const f32x4 c0 = splat4(lane_on ? cinit[r] : NEG);
#pragma unroll
        for (int kb = 0; kb < 4; ++kb) { s[kb] = __builtin_amdgcn_mfma_f32_16x16x32_bf16(kf[kb][0], qf[r][0], c0, 0, 0, 0); s[kb] = __builtin_amdgcn_mfma_f32_16x16x32_bf16(kf[kb][1], qf[r][1], s[kb], 0, 0, 0); }
        if (KIND != 0) {
            const LAS float* bt = btab + hidx[r] * BT_PITCH;
            const int d0 = dbase + qi - 8 * fq * (KIND == 2 ? 64 : 1);
#pragma unroll
            for (int kb = 0; kb < 4; ++kb)
#pragma unroll
                for (int e = 0; e < 4; ++e) { const int ko = 32 * (kb >> 1) + 4 * (kb & 1) + e;
                    const int dist = d0 - ko * (KIND == 2 ? 64 : 1); const int dc = dist < 0 ? 0 : (dist > 128 ? 128 : dist);
                    float bv_ = bt[dc]; asm volatile("" : "+v"(bv_));
                    float x = s[kb][e] + bv_;
                    if (KIND == 2) x = dist < 0 ? NEG : x;
                    else { const int key = 8 * fq + ko; x = (key < klo || key > khi) ? NEG : x; }
                    s[kb][e] = x; }
        }
        float rs = 0.f;
#pragma unroll
        for (int kb = 0; kb < 4; ++kb)
#pragma unroll
            for (int e = 0; e < 4; ++e) { const float p = __builtin_amdgcn_exp2f(s[kb][e]); s[kb][e] = p; rs += p; }
        lsum[r] += rs;
        if (KIND == 2) { const float lt = fq_sum(rs); const float inv = lt > 0.f ? 1.0f / lt : 0.f;
#pragma unroll
            for (int kb = 0; kb < 4; ++kb) impacc[kb] += s[kb] * inv; }
#pragma unroll
        for (int ks = 0; ks < 2; ++ks) { v4u w; w.x = cvt_pk_bf16(s[2 * ks][0], s[2 * ks][1]); w.y = cvt_pk_bf16(s[2 * ks][2], s[2 * ks][3]); w.z = cvt_pk_bf16(s[2 * ks + 1][0], s[2 * ks + 1][1]); w.w = cvt_pk_bf16(s[2 * ks + 1][2], s[2 * ks + 1][3]);
            pf[r][ks] = __builtin_bit_cast(bf16x8, w); }
    }
    bf16x8 vf[4][2];
#pragma unroll
    for (int db = 0; db < 4; ++db)
#pragma unroll
        for (int ks = 0; ks < 2; ++ks) vf[db][ks] = *(const LAS bf16x8*)(vp + (db * 2 + ks) * 1024);
    __builtin_amdgcn_s_setprio(1);
#pragma unroll
    for (int r = 0; r < R; ++r)
#pragma unroll
        for (int db = 0; db < 4; ++db) { o[r][db] = __builtin_amdgcn_mfma_f32_16x16x32_bf16(vf[db][0], pf[r][0], o[r][db], 0, 0, 0); o[r][db] = __builtin_amdgcn_mfma_f32_16x16x32_bf16(vf[db][1], pf[r][1], o[r][db], 0, 0, 0); }
    __builtin_amdgcn_s_setprio(0);
}

__device__ __forceinline__ void nsa_unit(Frame& F, int b, int g, int i, const LAS float* btab, float B2) {
    int tid = F.tid; asm volatile("" : "+v"(tid));
    const int lane = tid & 63, w = F.wave, rho = lane & 15, fq = lane >> 4;
    const int qq = w & 3, hb = g * 6 + 3 * (w >> 2), qi = 16 * qq + rho, row = b * SEQ + 64 * i + qi;
    LAS unsigned char* lds = F.lds; unsigned char* ws = F.ws;
    const unsigned qoff = (unsigned)(row * 768 + hb * 64 + fq * 8) * 2u;
    bf16x8 qf[3][2];
#pragma unroll
    for (int r = 0; r < 3; ++r)
#pragma unroll
        for (int ds = 0; ds < 2; ++ds) qf[r][ds] = __builtin_bit_cast(bf16x8, ldg16(ws + WS_QB, qoff + (unsigned)(r * 64 + ds * 32) * 2u));
    const int hidx[3] = {hb, hb + 1, hb + 2};
    const float cnear[3] = {-B2, -B2, -B2};
    v2u out[3][4]; f32x4 o[3][4], impacc[4]; float lsum[3];
#pragma unroll
    for (int r = 0; r < 3; ++r) { lsum[r] = 0.f;
#pragma unroll
        for (int db = 0; db < 4; ++db) { out[r][db] = (v2u){0u, 0u}; o[r][db] = splat4(0.f); } }
#pragma unroll
    for (int kb = 0; kb < 4; ++kb) impacc[kb] = splat4(0.f);
#define AT_FINALIZE(br) do { _Pragma("unroll") for (int r = 0; r < 3; ++r) { const float l = fq_sum(lsum[r]); const float gt_ = *(const float*)((const char*)(ws + WS_G) + (unsigned)(row * 64 + hb * 3 + r * 3 + br) * 4u); const float inv = l > 0.f ? gt_ / l : 0.f; \
        _Pragma("unroll") for (int db = 0; db < 4; ++db) { const v2u pv_ = out[r][db]; const f32x4 t_ = o[r][db] * inv; \
            out[r][db].x = cvt_pk_bf16(__uint_as_float(pv_.x << 16) + t_[0], __uint_as_float(pv_.x & 0xffff0000u) + t_[1]); out[r][db].y = cvt_pk_bf16(__uint_as_float(pv_.y << 16) + t_[2], __uint_as_float(pv_.y & 0xffff0000u) + t_[3]); \
            o[r][db] = splat4(0.f); } lsum[r] = 0.f; } } while (0)
    const int bg = b * 2 + g;
    v4u kr, vr;
    if (tid < 128) ((LAS unsigned*)(lds + L_SEL))[tid] = 0u;
    { TileSrc tc{(const bf16*)(ws + WS_KCB) + (size_t)bg * 64 * 64, (const bf16*)(ws + WS_VCT) + (size_t)bg * 64 * 64, 64};
      tile_load(tc, tid, kr, vr); tile_store(lds, 3, tid, kr, vr); LDS_WAIT(); __syncthreads();
      att_step<3, 2>(lds + L_KBUF + 3 * TILE_B, lds + L_VBUF + 3 * TILE_B, qf, cnear, true, 0, 63, 64 * i - 63, qi, btab, hidx, o, lsum, impacc, lane);
      AT_FINALIZE(0); }
    unsigned long long sel;
    if (i >= 16) {
        LAS float* IMP = (LAS float*)(lds + L_IMP);
#pragma unroll
        for (int kb = 0; kb < 4; ++kb)
#pragma unroll
            for (int e = 0; e < 4; ++e) { const int c = 32 * (kb >> 1) + 8 * fq + 4 * (kb & 1) + e; IMP[((w >> 2) * 64 + c) * 64 + qi] = impacc[kb][e]; }
        LDS_WAIT(); __syncthreads();
        const int q = tid & 63, cg = tid >> 6; float val[8];
#pragma unroll
        for (int k = 0; k < 8; ++k) { const int c = cg * 8 + k; val[k] = IMP[c * 64 + q] + IMP[(64 + c) * 64 + q]; }
        LDS_WAIT(); __syncthreads();
#pragma unroll
        for (int k = 0; k < 8; ++k) IMP[(cg * 8 + k) * 64 + q] = val[k];
        LDS_WAIT(); __syncthreads();
        int cnt[8];
#pragma unroll
        for (int k = 0; k < 8; ++k) cnt[k] = 0;
#pragma unroll 4
        for (int c2 = 1; c2 <= i - 2; ++c2) { const float v2 = IMP[c2 * 64 + q];
#pragma unroll
            for (int k = 0; k < 8; ++k) cnt[k] += ((v2 > val[k]) || (v2 == val[k] && c2 < cg * 8 + k)) ? 1 : 0; }
        unsigned bits = 0u;
#pragma unroll
        for (int k = 0; k < 8; ++k) { const int c = cg * 8 + k; const bool s_ = (c == 0) || (c == i) || (c == i - 1) || (c >= 1 && c <= i - 2 && cnt[k] < 13); bits |= s_ ? (1u << k) : 0u; }
        if (bits) __hip_atomic_fetch_or((LAS unsigned*)(lds + L_SEL) + q * 2 + (cg >> 2), bits << ((cg & 3) * 8), __ATOMIC_RELAXED, __HIP_MEMORY_SCOPE_WORKGROUP);
        LDS_WAIT(); __syncthreads();
        const unsigned lo = ((LAS unsigned*)(lds + L_SEL))[qi * 2], hi = ((LAS unsigned*)(lds + L_SEL))[qi * 2 + 1];
        sel = ((unsigned long long)hi << 32) | lo;
    } else sel = (1ull << (i + 1)) - 1ull;
    const int nslc = i + 1, nslc2 = (nslc + 1) & ~1, w0 = i - 8 < 0 ? 0 : i - 8, nwin = i - w0 + 1, n2 = nslc2 + ((nwin + 1) & ~1);
    const bf16* KS = (const bf16*)(ws + WS_KSB) + (size_t)bg * SEQ * 64; const bf16* VS = (const bf16*)(ws + WS_VST) + (size_t)bg * 64 * SEQ;
    const bf16* KW = (const bf16*)(ws + WS_KWB) + (size_t)bg * SEQ * 64; const bf16* VW = (const bf16*)(ws + WS_VWT) + (size_t)bg * 64 * SEQ;
#define AT_TILE(s, isw, j, valid) const bool isw = (s) >= nslc2; const int j = isw ? w0 + ((s) - nslc2) : (s); const bool valid = (s) < n2 && (isw ? ((s) - nslc2) < nwin : (s) < nslc)
#define AT_LOAD(s) do { AT_TILE(s, w_, j_, v_); if (v_) { TileSrc t_{(w_ ? KW : KS) + (size_t)j_ * 64 * 64, (w_ ? VW : VS) + j_ * 64, SEQ}; tile_load(t_, tid, kr, vr); } } while (0)
#define AT_STORE(s) do { AT_TILE(s, w_, j_, v_); if (v_) tile_store(lds, (s) & 3, tid, kr, vr); } while (0)
#define AT_COMPUTE(s) do { AT_TILE(s, isw, j, v_); if (v_) { \
        const bool general = ((i - j) <= 2) || (isw && j == i - 8); const bool lane_on = isw ? true : (((sel >> j) & 1ull) != 0ull); const int sl = (s) & 3; \
        if (general) { const int khi = (j == i) ? qi : 63, klo = (isw && j == i - 8) ? qi : 0; \
            att_step<3, 1>(lds + L_KBUF + sl * TILE_B, lds + L_VBUF + sl * TILE_B, qf, cnear, lane_on, klo, khi, 64 * (i - j), qi, btab, hidx, o, lsum, impacc, lane); } \
        else { const float cfar[3] = {btab[hidx[0] * BT_PITCH + 128] - B2, btab[hidx[1] * BT_PITCH + 128] - B2, btab[hidx[2] * BT_PITCH + 128] - B2};     \
            att_step<3, 0>(lds + L_KBUF + sl * TILE_B, lds + L_VBUF + sl * TILE_B, qf, cfar, lane_on, 0, 63, 0, qi, btab, hidx, o, lsum, impacc, lane); } } } while (0)
    AT_LOAD(0); AT_STORE(0); AT_LOAD(1); AT_STORE(1); LDS_WAIT(); __syncthreads();
#pragma unroll 1
    for (int s = 0; s < n2; s += 2) {
        if (s == nslc2) AT_FINALIZE(1);
#pragma unroll 1
        for (int h2 = 0; h2 < 2; ++h2) { AT_LOAD(s + 2 + h2); AT_COMPUTE(s + h2); AT_STORE(s + 2 + h2); }
        LDS_WAIT(); __syncthreads();
    }
#undef AT_TILE
#undef AT_LOAD
#undef AT_STORE
#undef AT_COMPUTE
    AT_FINALIZE(2);
#undef AT_FINALIZE
    const unsigned moff = (unsigned)(row * DM + hb * 64 + 4 * fq) * 2u;
#pragma unroll
    for (int r = 0; r < 3; ++r)
#pragma unroll
        for (int db = 0; db < 4; ++db) *(v2u*)((char*)(ws + WS_MIX) + moff + (unsigned)(r * 64 + db * 16) * 2u) = out[r][db];
}

__device__ __forceinline__ void mem_unit(Frame& F, int layer, int b, int h, int qblk, float B2m) {
    int tid = F.tid; asm volatile("" : "+v"(tid));
    const int lane = tid & 63, w = F.wave, rho = lane & 15, fq = lane >> 4;
    const int row = b * SEQ + 128 * qblk + 16 * w + rho;
    LAS unsigned char* lds = F.lds; unsigned char* ws = F.ws;
    const bf16* Xq = (const bf16*)(ws + WS_XQB) + (size_t)row * 256 + h * 64 + fq * 8;
    bf16x8 qf[1][2]; qf[0][0] = *(const bf16x8*)Xq; qf[0][1] = *(const bf16x8*)(Xq + 32);
    const int hidx[1] = {0}; const float cinit[1] = {-B2m}; f32x4 o[1][4], impacc[4]; float lsum[1] = {0.f};
#pragma unroll
    for (int db = 0; db < 4; ++db) { o[0][db] = splat4(0.f); impacc[db] = splat4(0.f); }
    const bf16* K = (const bf16*)(ws + WS_MKB) + ((size_t)(layer * 32 + b * 4 + h) * NMEM) * 64; const bf16* V = (const bf16*)(ws + WS_MVT) + ((size_t)(layer * 32 + b * 4 + h) * 64) * NMEM;
    v4u kr, vr;
    { TileSrc t0{K, V, NMEM}; tile_load(t0, tid, kr, vr); tile_store(lds, 0, tid, kr, vr); LDS_WAIT(); __syncthreads(); }
#pragma unroll 1
    for (int s = 0; s < 4; ++s) {
        if (s + 1 < 4) { TileSrc t1{K + (size_t)(s + 1) * 64 * 64, V + (s + 1) * 64, NMEM}; tile_load(t1, tid, kr, vr); }
        att_step<1, 0>(lds + L_KBUF + (s & 1) * TILE_B, lds + L_VBUF + (s & 1) * TILE_B, qf, cinit, true, 0, 63, 0, 0, (const LAS float*)nullptr, hidx, o, lsum, impacc, lane);
        if (s + 1 < 4) tile_store(lds, (s + 1) & 1, tid, kr, vr);
        LDS_WAIT(); __syncthreads();
    }
    const float l = fq_sum(lsum[0]); const float inv = 1.0f / l;
    bf16* mix = (bf16*)(ws + WS_MIX) + (size_t)row * DM + 768 + h * 64 + 4 * fq;
#pragma unroll
    for (int db = 0; db < 4; ++db) { v2u wv; wv.x = cvt_pk_bf16(o[0][db][0] * inv, o[0][db][1] * inv); wv.y = cvt_pk_bf16(o[0][db][2] * inv, o[0][db][3] * inv); *(v2u*)(mix + db * 16) = wv; }
}

__device__ __forceinline__ void mem_unit4(Frame& F, int layer, int b, int h, int qblk0, float B2m) {
    int tid = F.tid; asm volatile("" : "+v"(tid));
    const int lane = tid & 63, w = F.wave, rho = lane & 15, fq = lane >> 4;
    LAS unsigned char* lds = F.lds; unsigned char* ws = F.ws;
    const bf16* K = (const bf16*)(ws + WS_MKB) + ((size_t)(layer * 32 + b * 4 + h) * NMEM) * 64; const bf16* V = (const bf16*)(ws + WS_MVT) + ((size_t)(layer * 32 + b * 4 + h) * 64) * NMEM;
    __syncthreads();
    { v4u kr[4], vr[4];
#pragma unroll
      for (int s = 0; s < 4; ++s) { TileSrc t{K + (size_t)s * 64 * 64, V + s * 64, NMEM}; tile_load(t, tid, kr[s], vr[s]); }
#pragma unroll
      for (int s = 0; s < 4; ++s) tile_store(lds, s, tid, kr[s], vr[s]);
      LDS_WAIT(); __syncthreads(); }
#pragma unroll 1
    for (int u4 = 0; u4 < 4; ++u4) {
        const int row = b * SEQ + 128 * (qblk0 + u4) + 16 * w + rho;
        const bf16* Xq = (const bf16*)(ws + WS_XQB) + (size_t)row * 256 + h * 64 + fq * 8;
        bf16x8 qf[1][2]; qf[0][0] = *(const bf16x8*)Xq; qf[0][1] = *(const bf16x8*)(Xq + 32);
        const int hidx[1] = {0}; const float cinit[1] = {-B2m}; f32x4 o[1][4], impacc[4]; float lsum[1] = {0.f};
#pragma unroll
        for (int db = 0; db < 4; ++db) { o[0][db] = splat4(0.f); impacc[db] = splat4(0.f); }
#pragma unroll
        for (int s = 0; s < 4; ++s)
            att_step<1, 0>(lds + L_KBUF + s * TILE_B, lds + L_VBUF + s * TILE_B, qf, cinit, true, 0, 63, 0, 0, (const LAS float*)nullptr, hidx, o, lsum, impacc, lane);
        const float l = fq_sum(lsum[0]); const float inv = 1.0f / l;
        bf16* mix = (bf16*)(ws + WS_MIX) + (size_t)row * DM + 768 + h * 64 + 4 * fq;
#pragma unroll
        for (int db = 0; db < 4; ++db) { v2u wv; wv.x = cvt_pk_bf16(o[0][db][0] * inv, o[0][db][1] * inv); wv.y = cvt_pk_bf16(o[0][db][2] * inv, o[0][db][3] * inv); *(v2u*)(mix + db * 16) = wv; }
    }
    LDS_WAIT(); __syncthreads();
}
}

namespace sm {
constexpr int W_QS = 0, W_PS = 1536, W_BYTES = 3584;
constexpr int S_PL = NWAVES * W_BYTES;
constexpr int S_LP = S_PL + 2 * 6 * 256 * 4, S_OP = S_LP + 2 * 4 * 8 * 4, S_SEL = S_OP + 2 * 4 * 6 * 64 * 4, S_ACC = S_SEL + 2 * 32 * 4, S_ACCL = S_ACC + 2 * 3 * 6 * 64 * 4, S_IMPS = S_ACCL + 2 * 3 * 8 * 4, S_CNT = S_IMPS + 2 * 256 * 4, S_END = S_CNT + 16;
static_assert(S_END <= 77824, "sample attention LDS map");

__device__ __forceinline__ float wsum_dpp(float x) {
    x += __builtin_bit_cast(float, __builtin_amdgcn_mov_dpp(__builtin_bit_cast(int, x), 0x128, 0xf, 0xf, false));
    x += __builtin_bit_cast(float, __builtin_amdgcn_mov_dpp(__builtin_bit_cast(int, x), 0x124, 0xf, 0xf, false));
    x += __builtin_bit_cast(float, __builtin_amdgcn_mov_dpp(__builtin_bit_cast(int, x), 0x122, 0xf, 0xf, false));
    x += __builtin_bit_cast(float, __builtin_amdgcn_mov_dpp(__builtin_bit_cast(int, x), 0x121, 0xf, 0xf, false));
    const int xi = __builtin_bit_cast(int, x);
    return (__builtin_bit_cast(float, __builtin_amdgcn_readlane(xi, 0)) + __builtin_bit_cast(float, __builtin_amdgcn_readlane(xi, 16))) + (__builtin_bit_cast(float, __builtin_amdgcn_readlane(xi, 32)) + __builtin_bit_cast(float, __builtin_amdgcn_readlane(xi, 48)));
}

template <int NH>
__device__ __forceinline__ void chunk_fb(const float* kb, const float* vb, int stride, int jlo, int jhi, const float (&bias2)[NH], const LAS float* qs, LAS float* ps,
                                         float (&lacc)[NH], float (&oacc)[NH], int lane, float (&pout)[NH]) {
    const int jr = lane < jlo ? jlo : (lane > jhi ? jhi : lane); const bool valid = (lane >= jlo) && (lane <= jhi);
    typedef const __attribute__((address_space(1))) char* gcp_t; gcp_t kbs, vbs;
    { const unsigned long long a = (unsigned long long)kb, c = (unsigned long long)vb;
      kbs = (gcp_t)(((unsigned long long)(unsigned)__builtin_amdgcn_readfirstlane((int)(a >> 32)) << 32) | (unsigned)__builtin_amdgcn_readfirstlane((int)a));
      vbs = (gcp_t)(((unsigned long long)(unsigned)__builtin_amdgcn_readfirstlane((int)(c >> 32)) << 32) | (unsigned)__builtin_amdgcn_readfirstlane((int)c)); }
    stride = __builtin_amdgcn_readfirstlane(stride); jlo = __builtin_amdgcn_readfirstlane(jlo); jhi = __builtin_amdgcn_readfirstlane(jhi);
    const unsigned koff = (unsigned)(jr * stride) * 4u, voff = (unsigned)lane * 4u;
    f32x4 kreg[16];
#pragma unroll
    for (int d4 = 0; d4 < 16; ++d4) kreg[d4] = *(const __attribute__((address_space(1))) f32x4*)(kbs + koff + d4 * 16);
    float s[NH];
#pragma unroll
    for (int h = 0; h < NH; ++h) s[h] = 0.f;
#pragma unroll
    for (int d4 = 0; d4 < 16; ++d4) { const f32x4 k4 = kreg[d4];
#pragma unroll
        for (int h = 0; h < NH; ++h) { const f32x4 q4 = *(const LAS f32x4*)(qs + h * 64 + d4 * 4); s[h] += (k4[0] * q4[0] + k4[1] * q4[1]) + (k4[2] * q4[2] + k4[3] * q4[3]); }
        if ((d4 & 3) == 3) asm volatile("" ::: "memory"); }
#pragma unroll
    for (int h = 0; h < NH; ++h) { const float p = valid ? __builtin_amdgcn_exp2f(s[h] + bias2[h]) : 0.f; pout[h] = p; lacc[h] += wsum_dpp(p); ps[lane * 8 + h] = p; }
    LDS_WAIT();
    constexpr int PVG = 32;
#pragma unroll 1
    for (int j0 = 0; j0 < 64; j0 += PVG) {
        if (j0 > jhi || j0 + PVG - 1 < jlo) continue;
        float vv[PVG];
#pragma unroll
        for (int q = 0; q < PVG; ++q) { const int j = j0 + q, jj = j < jlo ? jlo : (j > jhi ? jhi : j); vv[q] = *(const __attribute__((address_space(1))) float*)(vbs + (size_t)(jj * stride) * 4u + voff); }
        __builtin_amdgcn_sched_barrier(0);
#pragma unroll
        for (int q = 0; q < PVG; ++q) { const float v = vv[q]; const LAS float* pp = ps + (j0 + q) * 8;
            const f32x4 pa = *(const LAS f32x4*)pp;
            if (NH > 4) { const f32x4 pb = *(const LAS f32x4*)(pp + 4);
#pragma unroll
                for (int h = 4; h < NH; ++h) oacc[h] += pb[h - 4] * v; }
#pragma unroll
            for (int h = 0; h < (NH < 4 ? NH : 4); ++h) oacc[h] += pa[h] * v; }
        __builtin_amdgcn_sched_barrier(0);
    }
    LDS_WAIT();
}

template <int NH>
__device__ __forceinline__ void load_q(const float* q, LAS float* qs, int lane) { float t[NH];
#pragma unroll
    for (int h = 0; h < NH; ++h) t[h] = q[h * 64 + lane];
#pragma unroll
    for (int h = 0; h < NH; ++h) qs[h * 64 + lane] = t[h] * QSCALE_;
    LDS_WAIT(); }

__device__ __forceinline__ void nsa_sample(Frame& F, const LAS float* btab, float B2) {
    int tid = F.tid; asm volatile("" : "+v"(tid));
    const int lane = tid & 63, w = F.wave;
    LAS unsigned char* lds = F.lds; unsigned char* ws = F.ws;
    LAS float* qs = (LAS float*)(lds + w * W_BYTES + W_QS); LAS float* ps = (LAS float*)(lds + w * W_BYTES + W_PS);
    LAS float* PL = (LAS float*)(lds + S_PL); LAS float* LP = (LAS float*)(lds + S_LP); LAS float* OP = (LAS float*)(lds + S_OP); LAS int* SELL = (LAS int*)(lds + S_SEL);
    LAS float* ACC = (LAS float*)(lds + S_ACC); LAS float* ACCL = (LAS float*)(lds + S_ACCL);
    const float* Qf = (const float*)(ws + WS_Q); const float* Gf = (const float*)(ws + WS_G);
    const float* KCs = (const float*)(ws + WS_KC) + (size_t)CMP_ROWS_P * 64; const float* VCs = KCs + (size_t)CMP_ROWS * 64;
    const float* ck = FIN(F, I_CKV); const int* pt = (const int*)F.in[I_PT]; const float* cwin = FIN(F, I_CWIN);
#pragma unroll 1
    for (int rb = blockIdx.x; rb * 2 < MS * 2; rb += F.G) {
#ifndef NO_STAGEA
        {
            const int u = w >> 2, wq = w & 3, U = rb * 2 + u, rs = U >> 1, g = U & 1, b = rs >> 3, tl = rs & 7, t = PAST + tl, row = MP + rs;
            load_q<6>(Qf + (size_t)row * 768 + g * 384, qs, lane);
            const int c = wq * 64 + lane; int dist = t - (c * 64 + 63); dist = dist > 128 ? 128 : dist;
            float bias2[6], lacc[6], oacc[6], pout[6];
#pragma unroll
            for (int h = 0; h < 6; ++h) { bias2[h] = btab[(g * 6 + h) * 132 + dist] - B2; lacc[h] = 0.f; oacc[h] = 0.f; }
            const float* kb = KCs + ((size_t)(b * 256 + wq * 64) * 2 + g) * 64;
            chunk_fb<6>(kb, kb + (VCs - KCs), 128, 0, 63, bias2, qs, ps, lacc, oacc, lane, pout);
#pragma unroll
            for (int h = 0; h < 6; ++h) { PL[(u * 6 + h) * 256 + c] = pout[h]; OP[((u * 4 + wq) * 6 + h) * 64 + lane] = oacc[h]; if (lane == 0) LP[(u * 4 + wq) * 8 + h] = lacc[h]; }
            for (int k = tid; k < 2 * 3 * 6 * 64; k += NWAVES * 64) ACC[k] = 0.f;
            if (tid < 2 * 3 * 8) ACCL[tid] = 0.f;
        }
#endif
        LDS_WAIT(); __syncthreads();
        {
            const int u = w >> 2, wq = w & 3, U = rb * 2 + u, rs = U >> 1, g = U & 1, row = MP + rs, c = wq * 64 + lane;
            LAS float* IMPS = (LAS float*)(lds + S_IMPS); LAS int* CNT = (LAS int*)(lds + S_CNT);
            float il[6], imp = 0.f;
#pragma unroll
            for (int h = 0; h < 6; ++h) { const float l = LP[(u * 4 + 0) * 8 + h] + LP[(u * 4 + 1) * 8 + h] + LP[(u * 4 + 2) * 8 + h] + LP[(u * 4 + 3) * 8 + h]; il[h] = 1.0f / l; imp += PL[(u * 6 + h) * 256 + c] * il[h]; }
            IMPS[u * 256 + c] = imp;
            if (wq == 0) {
#pragma unroll
                for (int h = 0; h < 6; ++h) { const float o = OP[((u * 4 + 0) * 6 + h) * 64 + lane] + OP[((u * 4 + 1) * 6 + h) * 64 + lane] + OP[((u * 4 + 2) * 6 + h) * 64 + lane] + OP[((u * 4 + 3) * 6 + h) * 64 + lane];
                    ACC[((u * 3 + 0) * 6 + h) * 64 + lane] = Gf[(size_t)row * 64 + (g * 6 + h) * 3 + 0] * o * il[h]; }
                if (lane == 0) { SELL[u * 32 + 0] = 0; SELL[u * 32 + 1] = 255; CNT[u] = 0; }
                if (lane < 15) { const int j0_ = lane == 1 ? 255 : 0; const int pg = pt[(rs >> 3) * NPAGES + (j0_ >> 1)]; if (lane >= 2) SELL[u * 32 + lane] = -1; SELL[u * 32 + 16 + lane] = pg; }
            }
            LDS_WAIT(); __syncthreads();
            int cnt = 0;
#pragma unroll 8
            for (int c4 = 0; c4 < 256; c4 += 4) { const f32x4 v4 = *(const LAS f32x4*)(IMPS + u * 256 + c4);
#pragma unroll
                for (int e = 0; e < 4; ++e) { const int c2 = c4 + e; const bool cand = (c2 >= 1) && (c2 <= 254); cnt += (cand && ((v4[e] > imp) || (v4[e] == imp && c2 < c))) ? 1 : 0; } }
            if (c >= 1 && c <= 254 && cnt < 13) { const int slot = __hip_atomic_fetch_add(CNT + u, 1, __ATOMIC_RELAXED, __HIP_MEMORY_SCOPE_WORKGROUP); SELL[u * 32 + 2 + slot] = c; SELL[u * 32 + 18 + slot] = pt[(rs >> 3) * NPAGES + (c >> 1)]; }
        }
        LDS_WAIT(); __syncthreads();
#ifndef NO_STAGEB
        {
            struct SbTask { const float* kb; const float* vb; int stride, jlo, jhi, pos0, br, u, g, t; bool dead; };
            auto sb_task = [&](int tk) -> SbTask { SbTask T; const int u = tk / 25, k = tk % 25, U = rb * 2 + u, rs = U >> 1, g = U & 1, b = rs >> 3, tl = rs & 7;
                T.u = u; T.g = g; T.t = PAST + tl; T.jlo = 0; T.jhi = 63; T.dead = false;
                if (k < 15) { int j = __builtin_amdgcn_readfirstlane(SELL[u * 32 + k]); T.br = 1; if (j < 0) { T.dead = true; j = 0; }
                    const int page = __builtin_amdgcn_readfirstlane(SELL[u * 32 + 16 + k]); T.kb = ck + (((size_t)page * PAGE + (j & 1) * 64) * 4 + 2) * 128 + g * 64; T.stride = 512; T.pos0 = j * 64; }
                else if (k == 15) { T.br = 1; T.kb = F.out + O_KVS + (((size_t)b * DSEQ) * 4 + 2) * 128 + g * 64; T.stride = 512; T.pos0 = PAST; T.jhi = tl; }
                else if (k < 24) { T.br = 2; const int r0 = (k - 16) * 64; T.kb = cwin + ((size_t)b * 512 + r0) * 256 + g * 64; T.stride = 256; T.pos0 = PAST - 512 + r0; T.jlo = tl > r0 ? tl - r0 : 0; }
                else { T.br = 2; T.kb = F.out + O_WINS + ((size_t)b * 512 + 504) * 256 + g * 64; T.stride = 256; T.pos0 = PAST; T.jhi = tl; }
                T.vb = T.kb + 128; return T; };
            int cur_u = -1; float keep = 0.f;
            SbTask nx = sb_task(w);
#pragma unroll 1
            for (int tk = w; tk < 50; tk += NWAVES) {
                const SbTask T = nx;
                float t0 = 0.f, t1 = 0.f, t2 = 0.f, t3 = 0.f;
                if (tk + NWAVES < 50) { nx = sb_task(tk + NWAVES);
                    const int jr = lane < nx.jlo ? nx.jlo : (lane > nx.jhi ? nx.jhi : lane); const float* kp = nx.kb + (size_t)jr * nx.stride;
                    t0 = kp[0]; t1 = kp[32]; t2 = kp[128]; t3 = kp[160]; }
                if (T.u != cur_u) { const int U = rb * 2 + T.u; load_q<6>(Qf + (size_t)(MP + (U >> 1)) * 768 + T.g * 384, qs, lane); cur_u = T.u; }
                int dist = T.t - (T.pos0 + lane); dist = dist < 0 ? 0 : (dist > 128 ? 128 : dist);
                float bias2[6], lacc[6], oacc[6], pout[6];
#pragma unroll
                for (int h = 0; h < 6; ++h) { bias2[h] = T.dead ? -1e30f : btab[(T.g * 6 + h) * 132 + dist] - B2; lacc[h] = 0.f; oacc[h] = 0.f; }
                chunk_fb<6>(T.kb, T.vb, T.stride, T.jlo, T.jhi, bias2, qs, ps, lacc, oacc, lane, pout);
#pragma unroll
                for (int h = 0; h < 6; ++h) { __hip_atomic_fetch_add(ACC + ((T.u * 3 + T.br) * 6 + h) * 64 + lane, oacc[h], __ATOMIC_RELAXED, __HIP_MEMORY_SCOPE_WORKGROUP); if (lane == 0) __hip_atomic_fetch_add(ACCL + (T.u * 3 + T.br) * 8 + h, lacc[h], __ATOMIC_RELAXED, __HIP_MEMORY_SCOPE_WORKGROUP); }
                keep += (t0 + t1) + (t2 + t3);
            }
            if (keep == 1.2345e33f) ps[lane] = keep;
        }
#endif
        LDS_WAIT(); __syncthreads();
#pragma unroll 1
        for (int pr = w; pr < 12; pr += NWAVES) { const int u = pr / 6, h = pr % 6, U = rb * 2 + u, rs = U >> 1, g = U & 1, row = MP + rs;
            const float* gt = Gf + (size_t)row * 64 + (g * 6 + h) * 3;
            const float o = ACC[((u * 3 + 0) * 6 + h) * 64 + lane] + gt[1] * ACC[((u * 3 + 1) * 6 + h) * 64 + lane] / ACCL[(u * 3 + 1) * 8 + h] + gt[2] * ACC[((u * 3 + 2) * 6 + h) * 64 + lane] / ACCL[(u * 3 + 2) * 8 + h];
            ((bf16*)(ws + WS_MIX))[(size_t)row * DM + g * 384 + h * 64 + lane] = (bf16)(cvt_pk_bf16(o, 0.f) & 0xffffu); }
        LDS_WAIT(); __syncthreads();
    }
}

__device__ __forceinline__ void mem_sample(Frame& F, int layer, float B2m) {
    int tid = F.tid; asm volatile("" : "+v"(tid));
    const int lane = tid & 63, w = F.wave;
    LAS unsigned char* lds = F.lds; unsigned char* ws = F.ws;
    LAS float* qs = (LAS float*)(lds + w * W_BYTES + W_QS); LAS float* ps = (LAS float*)(lds + w * W_BYTES + W_PS);
    LAS float* ACC = (LAS float*)(lds + S_ACC); LAS float* ACCL = (LAS float*)(lds + S_ACCL);
#pragma unroll 1
    for (int tsk = blockIdx.x; tsk < DBATCH * 8; tsk += F.G) { const int b = tsk >> 3, h = (tsk >> 1) & 3, half = tsk & 1, row0 = MP + b * 8 + half * 4;
        if (tid < 4 * 64) ACC[tid] = 0.f; if (tid < 8) ACCL[tid] = 0.f;
        LDS_WAIT(); __syncthreads();
        if (w < 4) {
            const float* xq = (const float*)(ws + WS_XQ) + (size_t)row0 * 256 + h * 64 + lane;
            float t[4];
#pragma unroll
            for (int r = 0; r < 4; ++r) t[r] = xq[r * 256];
#pragma unroll
            for (int r = 0; r < 4; ++r) qs[r * 64 + lane] = t[r] * QSCALE_;
            LDS_WAIT();
            const float* kb = FIN(F, I_CMEM) + (((size_t)layer * DBATCH + b) * NMEM + w * 64) * 512 + h * 64;
            float bias2[4] = {-B2m, -B2m, -B2m, -B2m}, lacc[4] = {0.f, 0.f, 0.f, 0.f}, oacc[4] = {0.f, 0.f, 0.f, 0.f}, pout[4];
            chunk_fb<4>(kb, kb + 256, 512, 0, 63, bias2, qs, ps, lacc, oacc, lane, pout);
#pragma unroll
            for (int r = 0; r < 4; ++r) { __hip_atomic_fetch_add(ACC + r * 64 + lane, oacc[r], __ATOMIC_RELAXED, __HIP_MEMORY_SCOPE_WORKGROUP); if (lane == 0) __hip_atomic_fetch_add(ACCL + r, lacc[r], __ATOMIC_RELAXED, __HIP_MEMORY_SCOPE_WORKGROUP); }
        }
        LDS_WAIT(); __syncthreads();
        if (w < 4) ((bf16*)(ws + WS_MIX))[(size_t)(row0 + w) * DM + 768 + h * 64 + lane] = (bf16)(cvt_pk_bf16(ACC[w * 64 + lane] / ACCL[w], 0.f) & 0xffffu);
        LDS_WAIT(); __syncthreads();
    }
}
}
namespace sg {
typedef short bf16x8 __attribute__((ext_vector_type(8)));
__device__ __forceinline__ v4u ldg16(const void* ubase, unsigned off) { return *(const v4u*)((const char*)ubase + off); }

template <int RW, int MB, int NB>
__device__ __forceinline__ void tile_mm(Frame& F, const bf16* A, int r0, const bf16* Bt, int K, const int (&brow)[NB], f32x4 (&acc)[MB][NB], int tid, int w, int lane) {
    constexpr int KQ = 8 / RW, KS = 4 / KQ, CH = NB / 2;
    const int fr = lane & 15, fq = lane >> 4, rg = w % RW, kq = w / RW;
    LAS unsigned char* lds = F.lds;
    const unsigned a0 = (unsigned)((r0 + 16 * MB * rg + fr) * K + 32 * KS * kq + 8 * fq) * 2u;
    unsigned bsrc[CH], bdst[CH];
#pragma unroll
    for (int i = 0; i < CH; ++i) { const int id = tid * CH + i, n = id >> 4, c16 = id & 15; int br_ = brow[0];
#pragma unroll
        for (int nb = 1; nb < NB; ++nb) br_ = (n >> 4) == nb ? brow[nb] : br_;
        bsrc[i] = (unsigned)((br_ + (n & 15)) * K + c16 * 8) * 2u; bdst[i] = (unsigned)((((n >> 4) * 4 + (c16 >> 2)) * 64 + (n & 15) + 16 * (c16 & 3)) * 16); }
#pragma unroll
    for (int mb = 0; mb < MB; ++mb)
#pragma unroll
        for (int nb = 0; nb < NB; ++nb) acc[mb][nb] = (f32x4){0.f, 0.f, 0.f, 0.f};
    const int nst = K / 128;
    constexpr int D = 6, DB = 3;
    v4u ring[D][KS * MB];
#define SG_LDA(dst, s_) do { const unsigned o_ = (unsigned)((s_) < nst ? (s_) : nst - 1) * 256u; _Pragma("unroll") for (int mb = 0; mb < MB; ++mb) _Pragma("unroll") for (int j = 0; j < KS; ++j) dst[KS * mb + j] = ldg16(A, a0 + (unsigned)(16 * mb * K) * 2u + o_ + 64u * j); } while (0)
#pragma unroll
    for (int q = 0; q < D; ++q) SG_LDA(ring[q], q);
    v4u br[DB][CH];
#pragma unroll
    for (int j = 0; j < DB; ++j)
#pragma unroll
        for (int i = 0; i < CH; ++i) br[j][i] = ldg16(Bt, bsrc[i] + (unsigned)j * 256u);
#pragma unroll
    for (int i = 0; i < CH; ++i) *(LAS v4u*)(lds + bdst[i]) = br[0][i];
#pragma unroll
    for (int i = 0; i < CH; ++i) br[0][i] = ldg16(Bt, bsrc[i] + (unsigned)DB * 256u);
    LDS_WAIT(); __syncthreads();
#pragma unroll 1
    for (int s0 = 0; s0 < nst; s0 += D) {
#pragma unroll
        for (int q = 0; q < D; ++q) { const int s = s0 + q;
          if (s < nst) {
            const LAS unsigned char* bb = lds + (s & 1) * 16384 + kq * (KS * 1024) + lane * 16;
            bf16x8 af[KS * MB];
#pragma unroll
            for (int k = 0; k < KS * MB; ++k) af[k] = __builtin_bit_cast(bf16x8, ring[q][k]);
            SG_LDA(ring[q], s + D);
#pragma unroll
            for (int nb = 0; nb < NB; ++nb)
#pragma unroll
                for (int j = 0; j < KS; ++j) { const bf16x8 bf = *(const LAS bf16x8*)(bb + (nb * 4 + j) * 1024);
#pragma unroll
                    for (int mb = 0; mb < MB; ++mb) acc[mb][nb] = __builtin_amdgcn_mfma_f32_16x16x32_bf16(bf, af[KS * mb + j], acc[mb][nb], 0, 0, 0); }
            if (s + 1 < nst) {
#pragma unroll
                for (int i = 0; i < CH; ++i) *(LAS v4u*)(lds + ((s + 1) & 1) * 16384 + bdst[i]) = br[(q + 1) % DB][i];
                if (s + 1 + DB < nst) {
#pragma unroll
                    for (int i = 0; i < CH; ++i) br[(q + 1) % DB][i] = ldg16(Bt, bsrc[i] + (unsigned)(s + 1 + DB) * 256u); }
            }
            LDS_WAIT(); __syncthreads();
          }
        }
    }
#undef SG_LDA
    if (kq > 0) {
#pragma unroll
        for (int mb = 0; mb < MB; ++mb)
#pragma unroll
            for (int nb = 0; nb < NB; ++nb) *(LAS f32x4*)(lds + 32768 + (((((kq - 1) * RW + rg) * MB + mb) * NB + nb) * 64 + lane) * 16) = acc[mb][nb];
    }
    LDS_WAIT(); __syncthreads();
    if (kq == 0) {
#pragma unroll
        for (int p = 0; p < KQ - 1; ++p)
#pragma unroll
            for (int mb = 0; mb < MB; ++mb)
#pragma unroll
                for (int nb = 0; nb < NB; ++nb) acc[mb][nb] += *(const LAS f32x4*)(lds + 32768 + ((((p * RW + rg) * MB + mb) * NB + nb) * 64 + lane) * 16);
    }
}

template <bool BASEB>
__device__ __forceinline__ void resid(Frame& F, const bf16* A, const bf16* Bt, int K, const float* baseS, const bf16* baseB, float* outF, bf16* outB, float* ssq) {
    int tid = F.tid; asm volatile("" : "+v"(tid)); const int lane = tid & 63, w = F.wave, fr = lane & 15, fq = lane >> 4;
#pragma unroll 1
    for (int t = blockIdx.x; t < 256; t += F.G) { const int tn = t >> 3, mq = t & 7;
        int brow[2];
#pragma unroll
        for (int nb = 0; nb < 2; ++nb) brow[nb] = 32 * tn + 16 * nb;
        f32x4 acc[1][2];
        tile_mm<2, 1, 2>(F, A, MP + 32 * mq, Bt, K, brow, acc, tid, w, lane);
        if (w < 2) { const int rs = 32 * mq + 16 * w + fr, row = MP + rs; float ss = 0.f;
#pragma unroll
            for (int nb = 0; nb < 2; ++nb) { const int c = 32 * tn + 16 * nb + 4 * fq; f32x4 b;
                if (BASEB) { const v2u bw = *(const v2u*)(baseB + (size_t)row * DM + c); b = (f32x4){__uint_as_float(bw.x << 16), __uint_as_float(bw.x & 0xffff0000u), __uint_as_float(bw.y << 16), __uint_as_float(bw.y & 0xffff0000u)}; }
                else b = *(const f32x4*)(baseS + (size_t)rs * DM + c);
                const f32x4 y = b + acc[0][nb];
                if (outF) *(f32x4*)(outF + (size_t)row * DM + c) = y;
                if (outB) { v2u wv; wv.x = cvt_pk_bf16(y[0], y[1]); wv.y = cvt_pk_bf16(y[2], y[3]); *(v2u*)(outB + (size_t)row * DM + c) = wv; ss += (y[0] * y[0] + y[1] * y[1]) + (y[2] * y[2] + y[3] * y[3]); } }
            if (outB) { ss = fq_sum(ss); if (fq == 0) atomicAdd(ssq + row, ss); }
        }
    }
}

__device__ __forceinline__ void up(Frame& F, const bf16* A, const bf16* Bt, const float* ssq) {
    int tid = F.tid; asm volatile("" : "+v"(tid)); const int lane = tid & 63, w = F.wave, fr = lane & 15, fq = lane >> 4;
    float* US = (float*)(F.ws + WS_US);
#pragma unroll 1
    for (int t = blockIdx.x; t < NUP / 32; t += F.G) { const int tn = t >> 1, mh = t & 1;
        int brow[4];
#pragma unroll
        for (int nb = 0; nb < 4; ++nb) brow[nb] = 64 * tn + 16 * nb;
        f32x4 acc[2][4];
        tile_mm<4, 2, 4>(F, A, MP + 128 * mh, Bt, DM, brow, acc, tid, w, lane);
        if (w < 4) {
#pragma unroll
            for (int mb = 0; mb < 2; ++mb) { const int rs = 128 * mh + 32 * w + 16 * mb + fr; const float rstd = rsqrtf(ssq[MP + rs] * (1.0f / DM) + EPS);
#pragma unroll
                for (int nb = 0; nb < 4; ++nb) { const int n = 64 * tn + 16 * nb + 4 * fq, chn = ((n >> 7) & 1) * DFF + 128 * (n >> 8) + (n & 127); *(f32x4*)(US + (size_t)rs * NUP + chn) = acc[mb][nb] * rstd; }
            }
        }
    }
}

__device__ __forceinline__ void in1(Frame& F, const float* ssq) {
    int tid = F.tid; asm volatile("" : "+v"(tid)); const int lane = tid & 63, w = F.wave, fr = lane & 15, fq = lane >> 4;
    unsigned char* ws = F.ws;
#pragma unroll 1
    for (int t = blockIdx.x; t < 128; t += F.G) { const int th = t >> 3, mq = t & 7, pn = th >> 2, wc = th & 3;
        int brow[4];
#pragma unroll
        for (int nb = 0; nb < 4; ++nb) brow[nb] = 256 * pn + 128 * (nb >> 1) + 32 * wc + 16 * (nb & 1);
        f32x4 acc[1][4];
        tile_mm<2, 1, 4>(F, (const bf16*)(ws + WS_Y2B), MP + 32 * mq, (const bf16*)(ws + WS_WIN1), DM, brow, acc, tid, w, lane);
        if (w < 2) { const int rs = 32 * mq + 16 * w + fr, row = MP + rs; const float rstd = rsqrtf(ssq[row] * (1.0f / DM) + EPS);
            f32x4 z[4]; float ss = 0.f;
#pragma unroll
            for (int nb = 0; nb < 4; ++nb) { z[nb] = acc[0][nb] * rstd; ss += (z[nb][0] * z[nb][0] + z[nb][1] * z[nb][1]) + (z[nb][2] * z[nb][2] + z[nb][3] * z[nb][3]); }
            if (pn < 3) {
#pragma unroll
                for (int nb = 0; nb < 4; ++nb) { const int c = 256 * pn + 64 * wc + 16 * nb + 4 * fq;
                    *(f32x4*)((float*)(ws + WS_UP) + (size_t)row * 768 + c) = z[nb]; *(f32x4*)(F.out + O_POOLS + ((size_t)(rs >> 3) * 15 + 7 + (rs & 7)) * 768 + c) = z[nb]; }
            } else { ss = fq_sum(ss); const float hn = rsqrtf(ss * (1.0f / 64.0f) + EPS);
#pragma unroll
                for (int nb = 0; nb < 4; ++nb) { const int d = 16 * nb + 4 * fq; const f32x4 gx = *(const f32x4*)(FIN(F, I_XQG) + 64 + d); *(f32x4*)((float*)(ws + WS_XQ) + (size_t)row * 256 + wc * 64 + d) = z[nb] * hn * gx; }
            }
        }
    }
}
}

namespace cf {
typedef short bf16x8 __attribute__((ext_vector_type(8)));
constexpr int BBUF = 16384;
template <bool SAMPLE, int D>
__device__ __forceinline__ void cmp_tile(Frame& F, int b, int which, int c0, float* H1) {
    int tid = F.tid; asm volatile("" : "+v"(tid));
    const int lane = tid & 63, w = F.wave, rho = lane & 15, fq = lane >> 4;
    LAS unsigned char* lds = F.lds; unsigned char* ws = F.ws;
    const int c = c0 + 8 * w + (rho >> 1), g = rho & 1;
    const float* src;
    if (SAMPLE) { const int page = ((const int*)F.in[I_PT])[b * NPAGES + (c >> 1)]; src = FIN(F, I_CKV) + (((size_t)page * PAGE + (c & 1) * 64) * 4 + which) * 128 + g * 64 + 8 * fq; }
    else src = F.out + O_KVP + (((size_t)b * SEQ + c * 64) * 4 + which) * 128 + g * 64 + 8 * fq;
    const bf16* Bt = (const bf16*)(ws + WS_WC1B) + (size_t)which * 256 * 4096;
    unsigned bsrc[2], bdst[2];
#pragma unroll
    for (int i = 0; i < 2; ++i) { const int id = tid * 2 + i, h = id >> 3, c8 = id & 7; bsrc[i] = (unsigned)(h * 4096 + c8 * 8) * 2u; bdst[i] = (unsigned)((((h >> 4) * 2 + (c8 >> 2)) * 64 + (h & 15) + 16 * (c8 & 3)) * 16); }
    f32x4 acc[8];
#pragma unroll
    for (int nb = 0; nb < 8; ++nb) acc[nb] = (f32x4){0.f, 0.f, 0.f, 0.f};
    f32x4 ar[D][4];
#define CF_LD4(p__) (SAMPLE ? __builtin_nontemporal_load((const f32x4*)(p__)) : *(const f32x4*)(p__))
#define CF_LDA(dst, l_) do { const float* p_ = src + (size_t)((l_) < 64 ? (l_) : 63) * 512; dst[0] = CF_LD4(p_); dst[1] = CF_LD4(p_ + 4); dst[2] = CF_LD4(p_ + 32); dst[3] = CF_LD4(p_ + 36); } while (0)
#pragma unroll
    for (int q = 0; q < D - 1; ++q) CF_LDA(ar[q], q);
    v4u br[2];
#pragma unroll
    for (int i = 0; i < 2; ++i) br[i] = *(const v4u*)((const char*)Bt + bsrc[i]);
#pragma unroll
    for (int i = 0; i < 2; ++i) *(LAS v4u*)(lds + bdst[i]) = br[i];
    LDS_WAIT(); __syncthreads();
#pragma unroll
    for (int i = 0; i < 2; ++i) br[i] = *(const v4u*)((const char*)Bt + bsrc[i] + 128u);
#pragma unroll 1
    for (int l0 = 0; l0 < 64; l0 += D) {
#pragma unroll
        for (int q = 0; q < D; ++q) { const int l = l0 + q;
            const LAS unsigned char* bb = lds + (l & 1) * BBUF + lane * 16;
            bf16x8 af[2];
#pragma unroll
            for (int ks = 0; ks < 2; ++ks) { v4u t; t.x = cvt_pk_bf16(ar[q][2 * ks][0], ar[q][2 * ks][1]); t.y = cvt_pk_bf16(ar[q][2 * ks][2], ar[q][2 * ks][3]); t.z = cvt_pk_bf16(ar[q][2 * ks + 1][0], ar[q][2 * ks + 1][1]); t.w = cvt_pk_bf16(ar[q][2 * ks + 1][2], ar[q][2 * ks + 1][3]);
                af[ks] = __builtin_bit_cast(bf16x8, t); }
            CF_LDA(ar[(q + D - 1) % D], l + D - 1);
#pragma unroll
            for (int nb = 0; nb < 8; ++nb)
#pragma unroll
                for (int ks = 0; ks < 2; ++ks) { const bf16x8 bf = *(const LAS bf16x8*)(bb + (nb * 2 + ks) * 1024); acc[nb] = __builtin_amdgcn_mfma_f32_16x16x32_bf16(bf, af[ks], acc[nb], 0, 0, 0); }
            if (l + 1 < 64) {
#pragma unroll
                for (int i = 0; i < 2; ++i) *(LAS v4u*)(lds + ((l + 1) & 1) * BBUF + bdst[i]) = br[i];
                if (l + 2 < 64) {
#pragma unroll
                    for (int i = 0; i < 2; ++i) br[i] = *(const v4u*)((const char*)Bt + bsrc[i] + (unsigned)(l + 2) * 128u); }
            }
            LDS_WAIT(); __syncthreads();
        }
    }
#undef CF_LDA
#undef CF_LD4
    const int row = SAMPLE ? CMP_ROWS_P + (b * 256 + c) * 2 + g : (b * 64 + c) * 2 + g;
    const float* b1 = FIN(F, I_CB1) + which * 128; const float* b1e = (const float*)(ws + WS_CTL) + CW_B1EFF + which * 128;
    float* dst = H1 + ((size_t)which * CMP_ROWS + row) * 128 + 4 * fq;
    f32x4 bb[8];
#pragma unroll
    for (int nb = 0; nb < 8; ++nb) bb[nb] = *(const f32x4*)(b1 + 16 * nb + 4 * fq) + *(const f32x4*)(b1e + 16 * nb + 4 * fq);
    __builtin_amdgcn_sched_barrier(0);
#pragma unroll
    for (int nb = 0; nb < 8; ++nb) { f32x4 o;
#pragma unroll
        for (int e = 0; e < 4; ++e) o[e] = gelu_tanh(acc[nb][e] + bb[nb][e]);
        *(f32x4*)(dst + 16 * nb) = o; }
}

__device__ __forceinline__ void cmp_tile_p32(Frame& F, int b, int which, int c0, float* H1) {
    int tid = F.tid; asm volatile("" : "+v"(tid));
    const int lane = tid & 63, w = F.wave, rho = lane & 15, fq = lane >> 4, rg = w & 1, kq = w >> 1;
    LAS unsigned char* lds = F.lds; unsigned char* ws = F.ws;
    const int c = c0 + 8 * rg + (rho >> 1), g = rho & 1;
    const float* src = F.out + O_KVP + (((size_t)b * SEQ + c * 64 + (kq >> 1)) * 4 + which) * 128 + g * 64 + 32 * (kq & 1) + 8 * fq;
    const bf16* Bt = (const bf16*)(ws + WS_WC1B) + (size_t)which * 256 * 4096;
    unsigned bsrc[4], bdst[4];
#pragma unroll
    for (int i = 0; i < 4; ++i) { const int id = tid * 4 + i, n = id >> 4, c16 = id & 15; bsrc[i] = (unsigned)(n * 4096 + c16 * 8) * 2u; bdst[i] = (unsigned)((((n >> 4) * 4 + (c16 >> 2)) * 64 + (n & 15) + 16 * (c16 & 3)) * 16); }
    f32x4 acc[8];
#pragma unroll
    for (int nb = 0; nb < 8; ++nb) acc[nb] = (f32x4){0.f, 0.f, 0.f, 0.f};
    constexpr int NST = 32, D = 4, DB = 2, PBUF = 32768;
    f32x4 ring[D][2];
#define CP_LDA(dst, s_) do { const float* p_ = src + (size_t)((s_) < NST ? (s_) : NST - 1) * 1024; dst[0] = *(const f32x4*)p_; dst[1] = *(const f32x4*)(p_ + 4); } while (0)
#pragma unroll
    for (int q = 0; q < D; ++q) CP_LDA(ring[q], q);
    v4u br[DB][4];
#pragma unroll
    for (int j = 0; j < DB; ++j)
#pragma unroll
        for (int i = 0; i < 4; ++i) br[j][i] = *(const v4u*)((const char*)Bt + bsrc[i] + (unsigned)j * 256u);
#pragma unroll
    for (int i = 0; i < 4; ++i) *(LAS v4u*)(lds + bdst[i]) = br[0][i];
#pragma unroll
    for (int i = 0; i < 4; ++i) br[0][i] = *(const v4u*)((const char*)Bt + bsrc[i] + (unsigned)DB * 256u);
    LDS_WAIT(); __syncthreads();
#pragma unroll 1
    for (int s0 = 0; s0 < NST; s0 += D) {
#pragma unroll
        for (int q = 0; q < D; ++q) { const int s = s0 + q;
            const LAS unsigned char* bb = lds + (s & 1) * PBUF + kq * 1024 + lane * 16;
            v4u t; t.x = cvt_pk_bf16(ring[q][0][0], ring[q][0][1]); t.y = cvt_pk_bf16(ring[q][0][2], ring[q][0][3]); t.z = cvt_pk_bf16(ring[q][1][0], ring[q][1][1]); t.w = cvt_pk_bf16(ring[q][1][2], ring[q][1][3]);
            const bf16x8 af = __builtin_bit_cast(bf16x8, t);
            CP_LDA(ring[q], s + D);
#pragma unroll
            for (int nb = 0; nb < 8; ++nb) { const bf16x8 bf = *(const LAS bf16x8*)(bb + nb * 4096); acc[nb] = __builtin_amdgcn_mfma_f32_16x16x32_bf16(bf, af, acc[nb], 0, 0, 0); }
            if (s + 1 < NST) {
#pragma unroll
                for (int i = 0; i < 4; ++i) *(LAS v4u*)(lds + ((s + 1) & 1) * PBUF + bdst[i]) = br[(q + 1) % DB][i];
                if (s + 1 + DB < NST) {
#pragma unroll
                    for (int i = 0; i < 4; ++i) br[(q + 1) % DB][i] = *(const v4u*)((const char*)Bt + bsrc[i] + (unsigned)(s + 1 + DB) * 256u); }
            }
            LDS_WAIT(); __syncthreads();
        }
    }
#undef CP_LDA
    if (kq > 0) {
#pragma unroll
        for (int nb = 0; nb < 8; ++nb) *(LAS f32x4*)(lds + 65536 + ((((kq - 1) * 2 + rg) * 8 + nb) * 64 + lane) * 16) = acc[nb];
    }
    LDS_WAIT(); __syncthreads();
    if (kq == 0) {
#pragma unroll
        for (int p = 0; p < 3; ++p)
#pragma unroll
            for (int nb = 0; nb < 8; ++nb) acc[nb] += *(const LAS f32x4*)(lds + 65536 + (((p * 2 + rg) * 8 + nb) * 64 + lane) * 16);
        const int row = (b * 64 + c) * 2 + g;
        const float* b1 = FIN(F, I_CB1) + which * 128; const float* b1e = (const float*)(ws + WS_CTL) + CW_B1EFF + which * 128;
        float* dst = H1 + ((size_t)which * CMP_ROWS + row) * 128 + 4 * fq;
        f32x4 bb4[8];
#pragma unroll
        for (int nb = 0; nb < 8; ++nb) bb4[nb] = *(const f32x4*)(b1 + 16 * nb + 4 * fq) + *(const f32x4*)(b1e + 16 * nb + 4 * fq);
        __builtin_amdgcn_sched_barrier(0);
#pragma unroll
        for (int nb = 0; nb < 8; ++nb) { f32x4 o;
#pragma unroll
            for (int e = 0; e < 4; ++e) o[e] = gelu_tanh(acc[nb][e] + bb4[nb][e]);
            *(f32x4*)(dst + 16 * nb) = o; }
    }
}
}
constexpr int ATT_QS = 0, ATT_PS = 1536, ATT_LG = 3584, ATT_WAVE_BYTES = 3584 + 6144, ATT_SHARED = NWAVES * ATT_WAVE_BYTES, ATT_RELB = 100352, ATT_BKT = ATT_RELB + 1536, ATT_BTAB = ATT_BKT + 512, ATT_CONST = ATT_BTAB + 12 * 132 * 4;
static_assert(ATT_SHARED <= ATT_RELB && ATT_CONST + 64 <= RING_BYTES, "attention LDS map");
constexpr float NEGBIG = -1e30f;

__device__ __forceinline__ void attn_tables(Frame& F, int layer) {
    LAS float* relb = (LAS float*)(F.lds + ATT_RELB); LAS int* bkt = (LAS int*)(F.lds + ATT_BKT); LAS float* btab = (LAS float*)(F.lds + ATT_BTAB); LAS float* cst = (LAS float*)(F.lds + ATT_CONST);
    if (layer == 0 && F.tid < 384) relb[F.tid] = FIN(F, I_RELB)[F.tid];
    if (layer == 0 && F.tid < 128) { const int n = F.tid; int v = n;
        if (n >= 16) { const float nf = (float)n; int lg = 16 + (int)(logf(nf / 16.0f) / 2.0794415416798357f * 16.0f); v = lg > 31 ? 31 : lg; }
        bkt[n] = v; }
    if (F.wave == 7) {
        const float mq = wave_max(fabsf(FIN(F, I_QG)[F.lane])), mk = wave_max(fabsf(FIN(F, I_KG)[F.lane]));
        float mb = 0.f; for (int k = F.lane; k < 384; k += 64) mb = fmaxf(mb, fabsf(FIN(F, I_RELB)[k])); mb = wave_max(mb);
        const float mxq = wave_max(fabsf(FIN(F, I_XQG)[layer * 64 + F.lane])), mxk = wave_max(fabsf(FIN(F, I_XKG)[layer * 64 + F.lane]));
        if (F.lane == 0) { cst[0] = (8.0f * mq * mk + mb) * 1.4426950408889634f; cst[1] = 8.0f * mxq * mxk * 1.4426950408889634f; } }
    __syncthreads();
    if (layer != 0) return;
    for (int k = F.tid; k < 12 * 129; k += NWAVES * 64) { const int h = k / 129, d = k % 129; btab[h * 132 + d] = relb[(d >= 128 ? 31 : bkt[d]) * 12 + h] * 1.4426950408889634f; }
    __syncthreads();
}

__device__ __forceinline__ int vcu_of(Frame& F) { const int bx = blockIdx.x; return (F.G % 8 == 0) ? (bx % 8) * (F.G / 8) + bx / 8 : bx; }

__device__ __forceinline__ void p4_attention0(Frame& F) {
    attn_tables(F, 0);
    const LAS float* btab = (const LAS float*)(F.lds + ATT_BTAB); const float B2 = ((const LAS float*)(F.lds + ATT_CONST))[0], B2m = ((const LAS float*)(F.lds + ATT_CONST))[1];
    sm::nsa_sample(F, btab, B2);
    sm::mem_sample(F, 0, B2m);
    __syncthreads();
#ifndef NO_PROMPT
    const int vcu = vcu_of(F);
#pragma unroll 1
    for (int idx = vcu; idx < 1024; idx += F.G) { const int vc = idx & 255, u4 = idx >> 8, bg = vc >> 4, k = vc & 15; const int i = u4 == 0 ? 63 - k : (u4 == 1 ? 32 + k : (u4 == 2 ? 31 - k : k));
        at::nsa_unit(F, bg >> 1, bg & 1, i, btab, B2); }
#pragma unroll 1
    for (int vc = vcu; vc < 256; vc += F.G) { const int bh = vc >> 3; at::mem_unit4(F, 0, bh >> 2, bh & 3, (vc & 7) * 4, B2m); }
#endif
}

template <int W>
__device__ __forceinline__ void pool_chunk(const float* __restrict__ up  , bf16* __restrict__ mix, int t0  ) {
    float hist[16];
#pragma unroll
    for (int i = 0; i < 16; ++i) hist[i] = (t0 > 0) ? up[(long)(i - 16) * 768] : 0.f;
    float s = 0.f;
#pragma unroll
    for (int i = 16 - (W - 1); i < 16; ++i) s += hist[i];
#pragma unroll 1
    for (int blk = 0; blk < 4; ++blk) {
        float cur[16];
#pragma unroll
        for (int i = 0; i < 16; ++i) cur[i] = up[(long)(blk * 16 + i) * 768];
#pragma unroll
        for (int i = 0; i < 16; ++i) { const int t = t0 + blk * 16 + i;
            s += cur[i];
            const float cnt = (float)((t + 1) < W ? (t + 1) : W);
            mix[(long)(blk * 16 + i) * DM] = (bf16)(cvt_pk_bf16(s / cnt - cur[i], 0.f) & 0xffffu);
            s -= (i - (W - 1) >= 0) ? cur[i - (W - 1)] : hist[16 + i - (W - 1)]; }
#pragma unroll
        for (int i = 0; i < 16; ++i) hist[i] = cur[i];
    }
}

__device__ __forceinline__ void p10_pool_attn(Frame& F) {
    const float* UP = (const float*)(F.ws + WS_UP); const float* sp = FIN(F, I_SPOOL); bf16* MIX = (bf16*)(F.ws + WS_MIX);
#pragma unroll 1
    for (int task = F.gw; task < (MP / 64) * 12; task += F.NGW) { const int chunk = task / 12, strip = task % 12, row0 = chunk * 64, c = strip * 64 + F.lane, grp = strip / 3;
        const float* up = UP + (size_t)row0 * 768 + c; bf16* mix = MIX + (size_t)row0 * DM + c; const int t0 = row0 & 4095;
        if (grp == 0) pool_chunk<2>(up, mix, t0); else if (grp == 1) pool_chunk<4>(up, mix, t0); else if (grp == 2) pool_chunk<8>(up, mix, t0); else pool_chunk<16>(up, mix, t0); }
    { const int total = MS * 192, gt = F.gw * 64 + F.lane, GT = F.NGW * 64;
#pragma unroll 1
      for (int idx = gt; idx < total; idx += GT) { const int rs = idx / 192, c = (idx % 192) * 4, grp = c / 192, w = 2 << grp, row = MP + rs, b = rs >> 3, tl = rs & 7;
        const f32x4 u0 = *(const f32x4*)(UP + (size_t)row * 768 + c); f32x4 s = u0;
        f32x4 pv[15];
#pragma unroll
        for (int j = 1; j < 16; ++j) { const int je = j < w ? j : 0, tt = tl - je; const float* p_ = tt >= 0 ? UP + (size_t)(row - je) * 768 + c : sp + ((size_t)b * 15 + 15 + tt) * 768 + c; pv[j - 1] = *(const f32x4*)p_; }
#pragma unroll
        for (int j = 1; j < 16; ++j) { const float m_ = j < w ? 1.f : 0.f; s += pv[j - 1] * m_; }
        const f32x4 p = s / (float)w - u0;
        v2u o; o.x = cvt_pk_bf16(p[0], p[1]); o.y = cvt_pk_bf16(p[2], p[3]); *(v2u*)(MIX + (size_t)row * DM + c) = o; } }
    attn_tables(F, 1);
    const float B2m = ((const LAS float*)(F.lds + ATT_CONST))[1]; const int vcu = vcu_of(F);
    sm::mem_sample(F, 1, B2m);
    __syncthreads();
#pragma unroll 1
    for (int vc = vcu; vc < 256; vc += F.G) { const int bh = vc >> 3; at::mem_unit4(F, 1, bh >> 2, bh & 3, (vc & 7) * 4, B2m); }
}

#define P7_CONV4(o_) const f32x4 ba_ = *(const f32x4*)(cb + c), bv_ = *(const f32x4*)(cb + DFF + c), wa0_ = *(const f32x4*)(cw + c), wa1_ = *(const f32x4*)(cw + NUP + c), wa2_ = *(const f32x4*)(cw + 2 * NUP + c), \
        wv0_ = *(const f32x4*)(cw + DFF + c), wv1_ = *(const f32x4*)(cw + NUP + DFF + c), wv2_ = *(const f32x4*)(cw + 2 * NUP + DFF + c), \
        xa2_ = *(const f32x4*)(x2 + c), xa1_ = *(const f32x4*)(x1 + c), xa0_ = *(const f32x4*)(x0 + c), xv2_ = *(const f32x4*)(x2 + DFF + c), xv1_ = *(const f32x4*)(x1 + DFF + c), xv0_ = *(const f32x4*)(x0 + DFF + c); \
        _Pragma("unroll") for (int e = 0; e < 4; ++e) { const float ya = ba_[e] + wa0_[e] * xa2_[e] + wa1_[e] * xa1_[e] + wa2_[e] * xa0_[e]; const float yv = bv_[e] + wv0_[e] * xv2_[e] + wv1_[e] * xv1_[e] + wv2_[e] * xv0_[e]; o_[e] = ya * sigmoidf_(ya) * yv; }
__device__ __forceinline__ void p7_fixup(Frame& F, int layer) {
    const float* UB = (const float*)(F.ws + WS_UB); bf16* ACT = (bf16*)(F.ws + WS_ACT);
    const float* cw = FIN(F, I_CONVW) + (size_t)layer * 3 * NUP; const float* cb = FIN(F, I_CONVB) + (size_t)layer * NUP;
    const int total = 128 * 2 * (DFF / 4), gt = F.gw * 64 + F.lane, GT = F.NGW * 64;
    for (int idx = gt; idx < total; idx += GT) { const int c = (idx % (DFF / 4)) * 4, pr = idx / (DFF / 4), pm = pr >> 1, r = pr & 1;
        if ((pm & 15) == 0) continue;
        const float* x0 = UB + ((size_t)pm * 4 + r) * NUP; const float* x1 = r == 0 ? UB + ((size_t)(pm - 1) * 4 + 3) * NUP : UB + ((size_t)pm * 4 + 0) * NUP;
        const float* x2 = r == 0 ? UB + ((size_t)(pm - 1) * 4 + 2) * NUP : UB + ((size_t)(pm - 1) * 4 + 3) * NUP;
        float o[4]; P7_CONV4(o);
        v2u w; w.x = cvt_pk_bf16(o[0], o[1]); w.y = cvt_pk_bf16(o[2], o[3]); *(v2u*)(ACT + (size_t)(pm * 256 + r) * DFF + c) = w; }
    const float* US = (const float*)(F.ws + WS_US); const float* sc = FIN(F, I_SCONV) + (size_t)layer * DBATCH * 2 * NUP; float* cs = F.out + O_CONVS + (size_t)layer * DBATCH * 2 * NUP;
    const int total2 = MS * (DFF / 4);
    for (int idx = gt; idx < total2; idx += GT) { const int c = (idx % (DFF / 4)) * 4, rsi = idx / (DFF / 4), b = rsi >> 3, t8 = rsi & 7;
        const float* x0 = US + (size_t)rsi * NUP; const float* x1 = t8 >= 1 ? x0 - NUP : sc + ((size_t)b * 2 + 1) * NUP; const float* x2 = t8 >= 2 ? x0 - 2 * NUP : sc + ((size_t)b * 2 + t8) * NUP;
        float o[4]; P7_CONV4(o);
        if (t8 >= 6) { *(f32x4*)(cs + ((size_t)b * 2 + (t8 - 6)) * NUP + c) = xa0_; *(f32x4*)(cs + ((size_t)b * 2 + (t8 - 6)) * NUP + DFF + c) = xv0_; }
        v2u w; w.x = cvt_pk_bf16(o[0], o[1]); w.y = cvt_pk_bf16(o[2], o[3]); *(v2u*)(ACT + (size_t)(MP + rsi) * DFF + c) = w; }
}

#ifndef MK_N_LAUNCHES
#define MK_N_LAUNCHES 1
#endif
constexpr int NPH = 15;
constexpr int N_LAUNCHES = MK_N_LAUNCHES;

struct PanelOrder {
    int pm, nN, G, c;
    __device__ __forceinline__ bool next(int i, Unit& u) const { const int L = i * G + c; if (L >= nN) return false; u.pm = pm; u.pn = L; u.kc = 0; return true; }
    __device__ __forceinline__ void a_ready(const Unit&) const {}
    __device__ __forceinline__ void done(const Unit&) const {}
};
struct SplitOrder {
    int pm, nN, nK, G, c;
    __device__ __forceinline__ bool next(int i, Unit& u) const { const int L = i * G + c; if (L >= nN * nK) return false; u.pm = pm; u.pn = L % nN; u.kc = L / nN; return true; }
    __device__ __forceinline__ void a_ready(const Unit&) const {}
    __device__ __forceinline__ void done(const Unit&) const {}
};
struct EpiAtomicF32 {
    static constexpr bool PERM = true, AFTER_DRAIN = false;
    const bf16* baseB; float* outF;
    __device__ __forceinline__ void operator()(const f32x4 (&acc)[2][2][4][2], const Unit& u, int wr, int wc, int fr_in, int fq_in) const {
        int lane_ = fr_in + 16 * fq_in; asm volatile("" : "+v"(lane_)); const int fr = lane_ & 15, fq = lane_ >> 4;
#pragma unroll
        for (int ai = 0; ai < 2; ++ai)
#pragma unroll
            for (int m = 0; m < 4; ++m) { const int row = EPI_ROW(u, ai, wr, m, fr), c0 = u.pn * 128 + wc * 32 + 8 * fq;
                f32x4 y0 = acc[ai][0][m][0], y1 = acc[ai][0][m][1];
                if (u.kc == 0) { const v4u bw = *(const v4u*)((const char*)baseB + (unsigned)(row * DM + c0) * 2u);
                    y0 += (f32x4){__uint_as_float(bw.x << 16), __uint_as_float(bw.x & 0xffff0000u), __uint_as_float(bw.y << 16), __uint_as_float(bw.y & 0xffff0000u)};
                    y1 += (f32x4){__uint_as_float(bw.z << 16), __uint_as_float(bw.z & 0xffff0000u), __uint_as_float(bw.w << 16), __uint_as_float(bw.w & 0xffff0000u)}; }
                float* o = outF + (size_t)row * DM + c0;
#pragma unroll
                for (int e = 0; e < 4; ++e) { atomicAdd(o + e, y0[e]); atomicAdd(o + 4 + e, y1[e]); } }
    }
};
struct CmpOrder {
    int G, c;
    __device__ __forceinline__ bool next(int i, Unit& u) const { const int L = i * G + c; if (L >= 2 * (CMP_ROWS / 256)) return false; u.pm = L; u.pn = L >= CMP_ROWS / 256 ? 1 : 0; u.kc = 0; return true; }
    __device__ __forceinline__ void a_ready(const Unit&) const {}
    __device__ __forceinline__ void done(const Unit&) const {}
};
struct EpiCmp1Both {
    static constexpr bool PERM = true, AFTER_DRAIN = false;
    const float* b1; const float* b1eff; float* H1;
    __device__ __forceinline__ void operator()(const f32x4 (&acc)[2][2][4][2], const Unit& u, int wr, int wc, int fr, int fq) const {
        const int which = u.pm >= (CMP_ROWS / 256) ? 1 : 0; Unit u2 = u; u2.pm = u.pm - which * (CMP_ROWS / 256);
        EpiCmp1 e{which, b1, b1eff, H1}; e(acc, u2, wr, wc, fr, fq);
    }
};


#ifndef PHMASK
#define PHMASK 0x7fff
#endif
#define IN(k) (((PHMASK >> ((k) >= 11 ? (k) - 6 : (k))) & 1) && lo <= (k) && (k) < hi)
#define SEAM(k) do { if (IN(k) && IN((k) + 1)) xcd_barrier(bar); } while (0)
#ifndef PROBE_REP
#define PROBE_REP -1
#endif
#define PROBE_N(k) (PROBE_REP == (k) ? 2 : 1)
template <int layer>
__device__ __forceinline__ void layer_tail(Frame& F, const XcdBarrier& bar, int lo, int hi) {
    unsigned char* ws = F.ws; float* ssqA = (float*)(ws + WS_CTL) + CW_SSQ; bf16* MIX = (bf16*)(ws + WS_MIX);
    constexpr int pb = layer ? 11 : 5;
    bf16* YmidB = (bf16*)(ws + (layer ? WS_Y3B : WS_Y1B)); float* ssqMid = ssqA + (layer ? 2 : 0) * SSQ_STRIDE;
    if (IN(pb)) {
        const bf16* base = layer ? (const bf16*)(ws + WS_Y2B) : (const bf16*)(ws + WS_XB);
        sg::resid<true>(F, MIX, (const bf16*)(ws + WS_WOUT) + (size_t)layer * DM * DM, DM, nullptr, base, nullptr, YmidB, ssqMid); __syncthreads();
#pragma unroll 1
        for (int rep_ = 0; rep_ < (layer == 0 ? PROBE_N(5) : 1); ++rep_) {
            { pg8::Gemm g{MIX, (const bf16*)(ws + WS_WOUT) + (size_t)layer * DM * DM, MP, DM, DM, 0}; pg8::StaticOrder S; S.init(MP, DM, F.G, (int)blockIdx.x);
              EpiResidT<false> E{base, nullptr, rep_ ? (bf16*)nullptr : YmidB, rep_ ? (float*)nullptr : ssqMid};
              pg8::gemm_phase<EpiResidT<false>, pg8::StaticOrder, true, true>(F.lds + RING_OFF, g, S, E); }
            if (rep_ + 1 < (layer == 0 ? PROBE_N(5) : 1)) __syncthreads(); }
        SEAM(pb);
    }
    if (IN(pb + 1)) {
        sg::up(F, YmidB, (const bf16*)(ws + WS_WUP) + (size_t)layer * NUP * DM, ssqMid); __syncthreads();
        pg8::Gemm g{YmidB, (const bf16*)(ws + WS_WUP) + (size_t)layer * NUP * DM, MP, NUP, DM, 0}; pg8::StaticOrder S; S.init(MP, NUP, F.G, (int)blockIdx.x);
        EpiUpConv E{ssqMid, (bf16*)(ws + WS_ACT), (float*)(ws + WS_UB), (float*)(ws + WS_US), F.out + O_CONVP + (size_t)layer * NB * 2 * NUP,
                    FIN(F, I_CONVW) + (size_t)layer * 3 * NUP, FIN(F, I_CONVB) + (size_t)layer * NUP, F.lds};
#pragma unroll 1
        for (int rep_ = 0; rep_ < (layer == 0 ? PROBE_N(6) : 1); ++rep_) {
            pg8::gemm_phase<EpiUpConv, pg8::StaticOrder, true, true>(F.lds + RING_OFF, g, S, E); if (rep_ + 1 < (layer == 0 ? PROBE_N(6) : 1)) __syncthreads(); }
        SEAM(pb + 1);
    }
    if (IN(pb + 2)) { p7_fixup(F, layer); SEAM(pb + 2); }
    if (IN(pb + 3)) {
#pragma unroll 1
        for (int rep_ = 0; rep_ < (layer == 0 ? PROBE_N(8) : 1); ++rep_) {
            float* oF = layer ? F.out + O_YP : (float*)nullptr; bf16* oB = (layer || rep_) ? (bf16*)nullptr : (bf16*)(ws + WS_Y2B); float* sq = (layer || rep_) ? (float*)nullptr : ssqA + SSQ_STRIDE;
            if (rep_ == 0) { sg::resid<true>(F, (const bf16*)(ws + WS_ACT), (const bf16*)(ws + WS_WDOWN) + (size_t)layer * DM * DFF, DFF, nullptr, YmidB, oF, oB, sq); __syncthreads(); }
            { pg8::Gemm g{(const bf16*)(ws + WS_ACT), (const bf16*)(ws + WS_WDOWN) + (size_t)layer * DM * DFF, MP, DM, DFF, 0}; pg8::StaticOrder S; S.init(MP, DM, F.G, (int)blockIdx.x);
              EpiResidT<false> E{YmidB, oF, oB, sq};
              pg8::gemm_phase<EpiResidT<false>, pg8::StaticOrder, true, true>(F.lds + RING_OFF, g, S, E); }
            if (rep_ + 1 < (layer == 0 ? PROBE_N(8) : 1)) __syncthreads(); }
        if (layer == 0) SEAM(pb + 3);
    }
}

__global__ void __launch_bounds__(NWAVES * 64, 2) mk_fwd(Args args) {
    extern __shared__ __attribute__((aligned(16))) unsigned char lds[];
    Frame F;
    F.lds = (LAS unsigned char*)lds; F.tid = threadIdx.x; F.lane = F.tid & 63; F.wave = __builtin_amdgcn_readfirstlane(F.tid >> 6);
    F.G = gridDim.x; F.gw = blockIdx.x * NWAVES + F.wave; F.NGW = F.G * NWAVES;
    F.in = args.in; F.out = args.out; F.ws = args.ws;
    unsigned char* ws = args.ws;
    unsigned* ctl = (unsigned*)(ws + WS_CTL);
    volatile LAS unsigned* MISC = (volatile LAS unsigned*)(F.lds + MISC_OFF);
    for (int u = F.tid; u < (LDS_BYTES - LDSCTL_OFF) / 4; u += NWAVES * 64) ((LAS unsigned*)(F.lds + LDSCTL_OFF))[u] = 0u;
    __syncthreads();
    XcdBarrier bar; bar.bar = ctl + CW_BAR; bar.x = 0; bar.st = nullptr;
    if (N_LAUNCHES == 1) bar = xcd_barrier_post(ctl + CW_BAR, MISC + 8);
    const int lo = args.ph_lo, hi = args.ph_hi;
    float* ssqA = (float*)ctl + CW_SSQ;
    bf16* XB = (bf16*)(ws + WS_XB); bf16* MIX = (bf16*)(ws + WS_MIX);

#ifndef PROBE_REP
#define PROBE_REP -1
#endif
    if (IN(0)) { p0_prologue(F, true); if (PROBE_REP == 0) { __syncthreads(); p0_prologue(F, false); } SEAM(0); }

    if (IN(1)) {
#pragma unroll 1
      for (int rep_ = 0; rep_ < PROBE_N(1); ++rep_) {
        { pg8::Gemm g{XB, (const bf16*)(ws + WS_WIN0), MP, NIN0, DM, 0}; pg8::StaticOrder S; S.init(MP, NIN0, F.G, (int)blockIdx.x);
          EpiInNsa E{(const float*)(ws + WS_SSQ0), FIN(F, I_QG), FIN(F, I_KG), FIN(F, I_XQG), (float*)(ws + WS_Q), (float*)(ws + WS_XQ), (float*)(ws + WS_G), F.out, (bf16*)(ws + WS_QB), (bf16*)(ws + WS_XQB), (bf16*)(ws + WS_KSB), (bf16*)(ws + WS_VST), (bf16*)(ws + WS_KWB), (bf16*)(ws + WS_VWT), F.lds};
          pg8::gemm_phase<EpiInNsa, pg8::StaticOrder, true, true>(F.lds + RING_OFF, g, S, E); }
        if (rep_ + 1 < PROBE_N(1)) __syncthreads(); }
        SEAM(1);
    }
    if (IN(2)) {
        float* H1 = (float*)(ws + WS_H1);
#pragma unroll 1
        for (int t = blockIdx.x; t < 256; t += F.G) { cf::cmp_tile<true, 8>(F, t >> 3, (t >> 2) & 1, (t & 3) * 64, H1); __syncthreads(); }
        const bool split = F.G >= 128; const int bx = (int)blockIdx.x;
        if (!split || (bx >= 64 && bx < 128)) {
#pragma unroll 1
            for (int t = split ? bx - 64 : bx; t < 64; t += F.G) { cf::cmp_tile_p32(F, t >> 3, (t >> 2) & 1, (t & 3) * 16, H1); __syncthreads(); } }
        if (!split || (bx >= 16 && bx < 48)) {
            pg8::Gemm g{(const bf16*)(ws + WS_MEMN), (const bf16*)(ws + WS_WMEM), NB * NMEM, 1024, DM, 0}; pg8::StaticOrder S; S.init(NB * NMEM, 1024, split ? 32 : F.G, split ? bx - 16 : bx);
            EpiMemKV E{FIN(F, I_XKG), F.out, (bf16*)(ws + WS_MKB), (bf16*)(ws + WS_MVT)};
            pg8::gemm_phase<EpiMemKV, pg8::StaticOrder, true, true>(F.lds + RING_OFF, g, S, E);
        }
        if (!split) __syncthreads();
        if (!split || (bx >= 48 && bx < 56)) {
            pg8::Gemm g{XB, (const bf16*)(ws + WS_WIN0), MT, NIN0, DM, 0}; PanelOrder S{MP / 256, NIN0 / 256, split ? 8 : F.G, split ? bx - 48 : bx};
            EpiInNsa E{(const float*)(ws + WS_SSQ0), FIN(F, I_QG), FIN(F, I_KG), FIN(F, I_XQG), (float*)(ws + WS_Q), (float*)(ws + WS_XQ), (float*)(ws + WS_G), F.out, (bf16*)(ws + WS_QB), (bf16*)(ws + WS_XQB), (bf16*)(ws + WS_KSB), (bf16*)(ws + WS_VST), (bf16*)(ws + WS_KWB), (bf16*)(ws + WS_VWT), F.lds};
            pg8::gemm_phase<EpiInNsa, PanelOrder, true, true>(F.lds + RING_OFF, g, S, E);
        }
        SEAM(2);
    }
    if (IN(3)) { p3_compress2(F); if (PROBE_REP == 3) { __syncthreads(); p3_compress2(F); } SEAM(3); }
    if (IN(4)) { p4_attention0(F); SEAM(4); }

    layer_tail<0>(F, bar, lo, hi);
            if (IN(9)) {
                sg::in1(F, ssqA + SSQ_STRIDE); __syncthreads();
                pg8::Gemm g{(const bf16*)(ws + WS_Y2B), (const bf16*)(ws + WS_WIN1), MP, DM, DM, 0}; pg8::StaticOrder S; S.init(MP, DM, F.G, (int)blockIdx.x);
                EpiInPool E{ssqA + SSQ_STRIDE, FIN(F, I_XQG) + 64, (float*)(ws + WS_UP), (float*)(ws + WS_XQ), F.out, (bf16*)(ws + WS_XQB)};
                pg8::gemm_phase<EpiInPool, pg8::StaticOrder, true, true>(F.lds + RING_OFF, g, S, E);
                SEAM(9);
            }
            if (IN(10)) { p10_pool_attn(F); if (PROBE_REP == 10) { __syncthreads(); p10_pool_attn(F); } SEAM(10); }
    layer_tail<1>(F, bar, lo, hi);
#undef IN
#undef SEAM
}

extern "C" void kernel_launch(void* const* d_in, const int* in_sizes, int n_in, void* d_out, int out_size, void* d_ws, size_t ws_size, hipStream_t stream) {
    static int grid = 0;
    if (grid == 0) {
        if (n_in != N_IN || (size_t)out_size != O_END || ws_size < WS_END) { fprintf(stderr, "kernel_launch: unexpected problem (n_in %d, out %d, ws %zu)\n", n_in, out_size, ws_size); grid = -1; return; }
        int dev = 0, cus = 0, per_cu = 0;
        if (hipGetDevice(&dev) != hipSuccess || hipDeviceGetAttribute(&cus, hipDeviceAttributeMultiprocessorCount, dev) != hipSuccess) { grid = -1; return; }
        if (hipFuncSetAttribute((const void*)mk_fwd, hipFuncAttributeMaxDynamicSharedMemorySize, LDS_BYTES) != hipSuccess) { fprintf(stderr, "kernel_launch: hipFuncSetAttribute failed\n"); grid = -1; return; }
        if (hipOccupancyMaxActiveBlocksPerMultiprocessor(&per_cu, (const void*)mk_fwd, NWAVES * 64, LDS_BYTES) != hipSuccess || per_cu < 1) { fprintf(stderr, "kernel_launch: occupancy query says %d\n", per_cu); }
        (void)hipGetLastError();
        grid = cus;
    }
    if (grid < 0) return;
    if (hipMemsetAsync((char*)d_ws + WS_CTL, 0, CTL_ZERO_BYTES, stream) != hipSuccess) return;
    Args a{};
    for (int i = 0; i < N_IN; ++i) a.in[i] = d_in[i];
    a.out = (float*)d_out; a.ws = (unsigned char*)d_ws;
    if (N_LAUNCHES == 1) { a.ph_lo = 0; a.ph_hi = NPH; hipLaunchKernelGGL(mk_fwd, dim3(grid), dim3(NWAVES * 64), LDS_BYTES, stream, a); }
    else for (int p = 0; p < NPH; ++p) { a.ph_lo = p; a.ph_hi = p + 1; hipLaunchKernelGGL(mk_fwd, dim3(grid), dim3(NWAVES * 64), LDS_BYTES, stream, a); }
}
```
